# Optimizing an MI355X kernel written in HIP

```python
import math
import jax, jax.numpy as jnp
from jax import lax
import numpy as np

D_MODEL = 1024
BATCH = 8
SEQ = 8192
DEPTH = 1

LRU_WIDTH = D_MODEL
LRU_BLOCKS = 16
LRU_BLOCK_W = LRU_WIDTH // LRU_BLOCKS
LRU_C = 8.0
CONV_K = 4
SSD_HEAD_DIM = 64
SSD_INNER = D_MODEL
SSD_HEADS = SSD_INNER // SSD_HEAD_DIM
SSD_GROUPS = 2
SSD_HPG = SSD_HEADS // SSD_GROUPS
SSD_STATE = 128
SSD_CHUNK = 128
MIX_WIDTH = LRU_WIDTH + SSD_INNER
SPLITS = (LRU_WIDTH, LRU_WIDTH, SSD_INNER, SSD_INNER,
          SSD_GROUPS * SSD_STATE, SSD_GROUPS * SSD_STATE, SSD_HEADS)
IN_COLS = sum(SPLITS)
SSD_CONV_CH = SSD_INNER + 2 * SSD_GROUPS * SSD_STATE
D_FF = -(-8 * D_MODEL // (3 * 256)) * 256
EPS = 1e-6

kernel_name = "hymba_style_rglru_ssd_hybrid"


def rms_norm(x, w):
    xf = x.astype(jnp.float32)
    y = xf * lax.rsqrt(jnp.mean(xf * xf, axis=-1, keepdims=True) + EPS)
    return (y * w.astype(jnp.float32)).astype(x.dtype)


def causal_depthwise_conv(x, w, b):
    K = w.shape[0]
    T = x.shape[1]
    xp = jnp.pad(x, ((0, 0), (K - 1, 0), (0, 0)))
    y = b + xp[:, 0:T] * w[0]
    for k in range(1, K):
        y = y + xp[:, k:k + T] * w[k]
    return y


def rg_lru(x, w_a, b_a, w_x, b_x, lam):
    bsz, T, W = x.shape
    xf = x.astype(jnp.float32)
    xb = xf.reshape(bsz, T, LRU_BLOCKS, LRU_BLOCK_W)
    r = jax.nn.sigmoid(jnp.einsum("btki,kij->btkj", xb, w_a.astype(jnp.float32)).reshape(bsz, T, W) + b_a.astype(jnp.float32))
    i = jax.nn.sigmoid(jnp.einsum("btki,kij->btkj", xb, w_x.astype(jnp.float32)).reshape(bsz, T, W) + b_x.astype(jnp.float32))
    log_a = -LRU_C * r * jax.nn.softplus(-lam.astype(jnp.float32))
    a = jnp.exp(log_a)
    u = jnp.sqrt(-jnp.expm1(2.0 * log_a)) * (i * xf)

    def combine(left, right):
        a1, b1 = left
        a2, b2 = right
        return a1 * a2, a2 * b1 + b2

    _, h = lax.associative_scan(combine, (a, u), axis=1)
    return h.astype(x.dtype)


def segsum(a):
    L = a.shape[-1]
    cs = jnp.cumsum(a, axis=-1)
    diff = cs[..., :, None] - cs[..., None, :]
    mask = jnp.tril(jnp.ones((L, L), dtype=bool))
    return jnp.where(mask, diff, -jnp.inf)


def ssd_chunked(xs, a, Bm, Cm):
    b, t, g, e, p = xs.shape
    n = Bm.shape[-1]
    c = t // SSD_CHUNK
    xs = xs.reshape(b, c, SSD_CHUNK, g, e, p)
    Bm = Bm.reshape(b, c, SSD_CHUNK, g, n)
    Cm = Cm.reshape(b, c, SSD_CHUNK, g, n)
    a = a.reshape(b, c, SSD_CHUNK, g, e).transpose(0, 3, 4, 1, 2)
    a_cs = jnp.cumsum(a, axis=-1)
    Lmat = jnp.exp(segsum(a))
    scores = jnp.einsum("bclgn,bcsgn->bgcls", Cm, Bm)
    M = scores[:, :, None] * Lmat
    y_diag = jnp.einsum("bgecls,bcsgep->bclgep", M, xs)
    decay_states = jnp.exp(a_cs[..., -1:] - a_cs)
    states = jnp.einsum("bclgn,bgecl,bclgep->bcgepn", Bm, decay_states, xs)
    chunk_a = jnp.pad(a_cs[..., -1], ((0, 0), (0, 0), (0, 0), (1, 0)))
    decay_chunk = jnp.exp(segsum(chunk_a))
    states = jnp.concatenate([jnp.zeros_like(states[:, :1]), states], axis=1)
    prev_states = jnp.einsum("bgezc,bcgepn->bzgepn", decay_chunk, states)[:, :-1]
    y_off = jnp.einsum("bclgn,bcgepn,bgecl->bclgep", Cm, prev_states, jnp.exp(a_cs))
    return (y_diag + y_off).reshape(b, t, g, e, p)


def setup_inputs(seed: int = 0) -> dict:
    key = jax.random.key(seed)
    ks = jax.random.split(key, 24)
    f32 = jnp.float32
    L = DEPTH

    def nrm(k, shape, scale):
        return jax.random.normal(k, shape, f32) * scale

    def gain(k, shape):
        return 1.0 + 0.05 * jax.random.normal(k, shape, f32)

    x = jax.random.normal(ks[0], (BATCH, SEQ, D_MODEL), f32)
    a_init = jax.random.uniform(ks[9], (L, LRU_WIDTH), f32, 0.9, 0.999)
    s = a_init ** (1.0 / LRU_C)
    lru_lambda = jnp.log(s) - jnp.log1p(-s)
    dt0 = jnp.exp(jax.random.uniform(ks[13], (L, SSD_HEADS), f32, math.log(1e-3), math.log(1e-1)))
    ssd_dt_bias = dt0 + jnp.log(-jnp.expm1(-dt0))
    ssd_a_log = jnp.log(jax.random.uniform(ks[14], (L, SSD_HEADS), f32, 1.0, 16.0))
    return {
        "x": x,
        "pre_mix_norm": gain(ks[1], (L, D_MODEL)),
        "w_in": nrm(ks[2], (L, D_MODEL, IN_COLS), D_MODEL ** -0.5),
        "lru_conv_w": nrm(ks[3], (L, CONV_K, LRU_WIDTH), CONV_K ** -0.5),
        "lru_conv_b": nrm(ks[4], (L, LRU_WIDTH), 0.01),
        "lru_wa": nrm(ks[5], (L, LRU_BLOCKS, LRU_BLOCK_W, LRU_BLOCK_W), LRU_BLOCK_W ** -0.5),
        "lru_ba": nrm(ks[6], (L, LRU_WIDTH), 0.01),
        "lru_wx": nrm(ks[7], (L, LRU_BLOCKS, LRU_BLOCK_W, LRU_BLOCK_W), LRU_BLOCK_W ** -0.5),
        "lru_bx": nrm(ks[8], (L, LRU_WIDTH), 0.01),
        "lru_lambda": lru_lambda,
        "lru_out_norm": gain(ks[10], (L, LRU_WIDTH)),
        "ssd_conv_w": nrm(ks[11], (L, CONV_K, SSD_CONV_CH), CONV_K ** -0.5),
        "ssd_conv_b": nrm(ks[12], (L, SSD_CONV_CH), 0.01),
        "ssd_dt_bias": ssd_dt_bias,
        "ssd_a_log": ssd_a_log,
        "ssd_d": gain(ks[15], (L, SSD_HEADS)),
        "ssd_out_norm": gain(ks[16], (L, SSD_INNER)),
        "w_out": nrm(ks[17], (L, MIX_WIDTH, D_MODEL), MIX_WIDTH ** -0.5),
        "post_mix_norm": gain(ks[18], (L, D_MODEL)),
        "pre_ffn_norm": gain(ks[19], (L, D_MODEL)),
        "w_gate": nrm(ks[20], (L, D_MODEL, D_FF), D_MODEL ** -0.5),
        "w_up": nrm(ks[21], (L, D_MODEL, D_FF), D_MODEL ** -0.5),
        "w_down": nrm(ks[22], (L, D_FF, D_MODEL), D_FF ** -0.5),
        "post_ffn_norm": gain(ks[23], (L, D_MODEL)),
    }


def reference(x, pre_mix_norm, w_in, lru_conv_w, lru_conv_b, lru_wa, lru_ba, lru_wx, lru_bx,
              lru_lambda, lru_out_norm, ssd_conv_w, ssd_conv_b, ssd_dt_bias, ssd_a_log, ssd_d,
              ssd_out_norm, w_out, post_mix_norm, pre_ffn_norm, w_gate, w_up, w_down, post_ffn_norm):
    bsz, T, _ = x.shape
    offs = np.cumsum((0,) + SPLITS)
    for li in range(DEPTH):
        h = rms_norm(x, pre_mix_norm[li])
        proj = h @ w_in[li]
        lru_x = proj[..., offs[0]:offs[1]]
        lru_gate = proj[..., offs[1]:offs[2]]
        ssd_z = proj[..., offs[2]:offs[3]]
        ssd_xbc = proj[..., offs[3]:offs[6]]
        ssd_dt = proj[..., offs[6]:offs[7]]

        lx = causal_depthwise_conv(lru_x, lru_conv_w[li], lru_conv_b[li])
        lh = rg_lru(lx, lru_wa[li], lru_ba[li], lru_wx[li], lru_bx[li], lru_lambda[li])
        y_lru = rms_norm(lh * jax.nn.gelu(lru_gate), lru_out_norm[li])

        xbc = jax.nn.silu(causal_depthwise_conv(ssd_xbc, ssd_conv_w[li], ssd_conv_b[li]))
        sx = xbc[..., :SSD_INNER].astype(jnp.float32).reshape(bsz, T, SSD_GROUPS, SSD_HPG, SSD_HEAD_DIM)
        sB = xbc[..., SSD_INNER:SSD_INNER + SSD_GROUPS * SSD_STATE].astype(jnp.float32).reshape(bsz, T, SSD_GROUPS, SSD_STATE)
        sC = xbc[..., SSD_INNER + SSD_GROUPS * SSD_STATE:].astype(jnp.float32).reshape(bsz, T, SSD_GROUPS, SSD_STATE)
        dt = jax.nn.softplus(ssd_dt.astype(jnp.float32) + ssd_dt_bias[li].astype(jnp.float32))
        dt = dt.reshape(bsz, T, SSD_GROUPS, SSD_HPG)
        A = -jnp.exp(ssd_a_log[li].astype(jnp.float32)).reshape(SSD_GROUPS, SSD_HPG)
        y = ssd_chunked(sx * dt[..., None], dt * A, sB, sC)
        y = y + ssd_d[li].astype(jnp.float32).reshape(SSD_GROUPS, SSD_HPG)[..., None] * sx
        y = y.reshape(bsz, T, SSD_INNER).astype(x.dtype)
        y_ssd = rms_norm(y * jax.nn.silu(ssd_z), ssd_out_norm[li])

        mix = jnp.concatenate([y_lru, y_ssd], axis=-1) @ w_out[li]
        x = x + rms_norm(mix, post_mix_norm[li])

        h = rms_norm(x, pre_ffn_norm[li])
        f = (jax.nn.silu(h @ w_gate[li]) * (h @ w_up[li])) @ w_down[li]
        x = x + rms_norm(f, post_ffn_norm[li])
    return x
```

```cpp
#include <hip/hip_runtime.h>
#include <cstdio>
#include <cstdint>
namespace pg8 {
#define PG8_LAS __attribute__((address_space(3)))
typedef unsigned short bf16_t;
typedef short bf16x8 __attribute__((ext_vector_type(8)));
typedef float f32x4 __attribute__((ext_vector_type(4)));
typedef unsigned u32x4 __attribute__((ext_vector_type(4)));
constexpr int BM = 256, BK = 64, HALF = 128, HTB = HALF * BK * 2  , STAGE_BYTES = 8 * HTB, NXCD = 8, WGM = 8;

__host__ __device__ __forceinline__ int lds_byte(int r, int c) { const int st = (r >> 4) * 2 + (c >> 5), rr = r & 15, cc = c & 31, ob = rr * 64 + cc * 2; return st * 1024 + (ob ^ (((ob >> 9) & 1) << 5)); }
__host__ __device__ __forceinline__ void stage_rc(int b, int& R, int& C) { const int st = b / 1024, sb = b % 1024, swz = sb ^ (((sb >> 9) & 1) << 5); R = (st >> 1) * 16 + swz / 64; C = (st & 1) * 32 + (swz % 64) / 2; }
__host__ __device__ __forceinline__ int perm32(int rho) { const int n = rho >> 4, i = rho & 15; return 8 * (i >> 2) + 4 * n + (i & 3); }

struct Unit { int pm, pn; };
struct Gemm { const bf16_t* A; const bf16_t* Bt; int M, N, K; };

struct StaticOrder {
    int nM, nN, nwg, G, c;
    __host__ __device__ void init(int M, int N, int G_, int c_) { nM = M / BM; nN = N / BM; nwg = nM * nN; G = G_; c = c_; }
    __host__ __device__ bool next(int i, Unit& u) const {
        const long L = (long)i * G + c; if (L >= nwg) return false;
        int wgid = (int)L; { const int q = nwg / NXCD, r = nwg % NXCD, xcd = wgid % NXCD, off = wgid / NXCD; wgid = (xcd < r ? xcd * (q + 1) : r * (q + 1) + (xcd - r) * q) + off; }
        const int nig = WGM * nN, gid = wgid / nig, fm = gid * WGM, gsz = (nM - fm) < WGM ? (nM - fm) : WGM;
        u.pm = fm + ((wgid % nig) % gsz); u.pn = (wgid % nig) / gsz; return true;
    }
    __device__ __forceinline__ void a_ready(const Unit&) const {}
    __device__ __forceinline__ void done(const Unit&) const {}
};

__device__ __forceinline__ unsigned cvt_pk_bf16(float lo, float hi) { unsigned r; asm volatile("v_cvt_pk_bf16_f32 %0, %1, %2" : "=v"(r) : "v"(lo), "v"(hi)); return r; }
typedef float f32x2 __attribute__((ext_vector_type(2)));
__device__ __forceinline__ f32x2 gelu_pk(f32x2 v) {
    const f32x2 av = __builtin_elementwise_abs(v), d = av * 0.2316418882f + 1.0f;
    f32x2 t; t.x = __builtin_amdgcn_rcpf(d.x); t.y = __builtin_amdgcn_rcpf(d.y);
    f32x2 q = t * 0.5307027145f + (-0.7265760135f); q = q * t + 0.7107068705f; q = q * t + (-0.142248368f); q = q * t + 0.127414796f; q = q * t;
    const f32x2 s = (v * v) * (-0.72134752044f);
    f32x2 e; e.x = __builtin_amdgcn_exp2f(s.x); e.y = __builtin_amdgcn_exp2f(s.y);
    const f32x2 m = v * (q * e), r = v - m;
    f32x2 o; o.x = v.x < 0.f ? m.x : r.x; o.y = v.y < 0.f ? m.y : r.y; return o;
}

template <int ACT  > struct EpiBf16 {
    static constexpr bool PERM = true, AFTER_DRAIN = false; static_assert(ACT == 0 || ACT == 1, "EpiBf16: ACT is 0 (none) or 1 (gelu_pk)");
    bf16_t* O; int ldc; const float* bias; int split_cols; size_t split_stride; float scale0;
    __device__ __forceinline__ void operator()(const f32x4 (&acc)[2][2][4][2], const Unit& u, int wr, int wc, int fr, int fq) const {
        const int row0 = u.pm * BM + wr * 64 + fr; int colt = u.pn * BM; bf16_t* base = O;
        float sc = 1.f; if (split_cols) { const int t = colt / split_cols; base += (size_t)t * split_stride; colt -= t * split_cols; if (t == 0) sc = scale0; }
        const int col0 = colt + wc * 32 + 8 * fq, bcol0 = u.pn * BM + wc * 32 + 8 * fq;
        f32x4 bv[2][2];
#pragma unroll
        for (int bj = 0; bj < 2; ++bj)
#pragma unroll
            for (int n = 0; n < 2; ++n) bv[bj][n] = bias ? *(const f32x4*)(bias + bcol0 + bj * HALF + 4 * n) : (f32x4){0.f, 0.f, 0.f, 0.f};
#pragma unroll
        for (int ai = 0; ai < 2; ++ai)
#pragma unroll
            for (int m = 0; m < 4; ++m) { bf16_t* rowp = base + (size_t)(row0 + ai * HALF + m * 16) * ldc + col0;
#pragma unroll
                for (int bj = 0; bj < 2; ++bj) { f32x4 v0 = acc[ai][bj][m][0] + bv[bj][0], v1 = acc[ai][bj][m][1] + bv[bj][1];
                    if (ACT == 1) { f32x2 a = gelu_pk((f32x2){v0[0], v0[1]}), b = gelu_pk((f32x2){v0[2], v0[3]}), c = gelu_pk((f32x2){v1[0], v1[1]}), d = gelu_pk((f32x2){v1[2], v1[3]});
                        v0 = (f32x4){a.x, a.y, b.x, b.y}; v1 = (f32x4){c.x, c.y, d.x, d.y}; }
                    v0 = v0 * sc; v1 = v1 * sc; u32x4 w; w.x = cvt_pk_bf16(v0[0], v0[1]); w.y = cvt_pk_bf16(v0[2], v0[3]); w.z = cvt_pk_bf16(v1[0], v1[1]); w.w = cvt_pk_bf16(v1[2], v1[3]);
                    *(u32x4*)(rowp + bj * HALF) = w; } }
    }
};
struct EpiSwiGLU {
    static constexpr bool PERM = true, AFTER_DRAIN = false;
    bf16_t* O; int ldc;
    __device__ __forceinline__ static float silu_mul(float g, float u) { return g * __builtin_amdgcn_rcpf(1.0f + __expf(-g)) * u; }
    __device__ __forceinline__ void operator()(const f32x4 (&acc)[2][2][4][2], const Unit& u, int wr, int wc, int fr, int fq) const {
        const int row0 = u.pm * BM + wr * 64 + fr; const int col0 = u.pn * HALF + wc * 32 + 8 * fq;
#pragma unroll
        for (int ai = 0; ai < 2; ++ai)
#pragma unroll
            for (int m = 0; m < 4; ++m) { bf16_t* rowp = O + (size_t)(row0 + ai * HALF + m * 16) * ldc + col0;
                const f32x4 g0 = acc[ai][0][m][0], g1 = acc[ai][0][m][1], u0 = acc[ai][1][m][0], u1 = acc[ai][1][m][1];
                u32x4 w; w.x = cvt_pk_bf16(silu_mul(g0[0], u0[0]), silu_mul(g0[1], u0[1])); w.y = cvt_pk_bf16(silu_mul(g0[2], u0[2]), silu_mul(g0[3], u0[3]));
                w.z = cvt_pk_bf16(silu_mul(g1[0], u1[0]), silu_mul(g1[1], u1[1])); w.w = cvt_pk_bf16(silu_mul(g1[2], u1[2]), silu_mul(g1[3], u1[3]));
                *(u32x4*)rowp = w; }
    }
};

template <class Epi, class Sched, bool ALIGN_EPI = false, bool SP2 = false>
__device__ __forceinline__ void gemm_phase(PG8_LAS unsigned char* lds, const Gemm g, const Sched& S, const Epi& E) {
    const int tid = threadIdx.x, wid = __builtin_amdgcn_readfirstlane(tid >> 6), lane = tid & 63, wr = wid >> 2, wc = wid & 3, fr = lane & 15, fq = lane >> 4;
    const int K = g.K, nt = K / BK;
    unsigned voffA[2], voffB[2];
#pragma unroll
    for (int i = 0; i < 2; ++i) { int R, C; stage_rc(tid * 16 + i * 8192, R, C); const int Rb = Epi::PERM ? ((R & ~31) + perm32(R & 31)) : R;
        voffA[i] = (unsigned)(R * K + C) * 2u; voffB[i] = (unsigned)(Rb * K + C) * 2u; }
    const size_t kstep = (size_t)(BK * 2);
    const size_t hstep = (size_t)HALF * K * 2;
    const size_t tstep = 2 * hstep;
    const unsigned ldsw = (unsigned)wid * 1024u;
    const int aoff = lds_byte(wr * 64 + fr, fq * 8), boff = lds_byte(wc * 32 + fr, fq * 8);
#define PG8_SA(b, h) (((b) * 2 + (h)) * HTB)
#define PG8_SB(b, h) ((4 + (b) * 2 + (h)) * HTB)
#define PG8_STAGE(bufoff, gbase, voff) do { _Pragma("unroll") for (int _i = 0; _i < 2; ++_i) \
        __builtin_amdgcn_global_load_lds((const unsigned*)((const char*)(gbase) + (voff)[_i]), (PG8_LAS unsigned*)(lds + (bufoff) + ldsw + _i * 8192), 16, 0, 0); } while (0)
#define PG8_LDA(dst, b, h) do { _Pragma("unroll") for (int m = 0; m < 4; ++m) _Pragma("unroll") for (int k = 0; k < 2; ++k) dst[m][k] = *(const PG8_LAS bf16x8*)(lds + PG8_SA(b, h) + aoff + m * 2048 + k * 1024); } while (0)
#define PG8_LDB(dst, b, h) do { _Pragma("unroll") for (int n = 0; n < 2; ++n) _Pragma("unroll") for (int k = 0; k < 2; ++k) dst[n][k] = *(const PG8_LAS bf16x8*)(lds + PG8_SB(b, h) + boff + n * 2048 + k * 1024); } while (0)
#define PG8_MMA(ai, bj, At, Bt) do { __builtin_amdgcn_s_setprio(1); _Pragma("unroll") for (int m = 0; m < 4; ++m) _Pragma("unroll") for (int n = 0; n < 2; ++n) _Pragma("unroll") for (int k = 0; k < 2; ++k) \
        acc[ai][bj][m][n] = __builtin_amdgcn_mfma_f32_16x16x32_bf16(Bt[n][k], At[m][k], acc[ai][bj][m][n], 0, 0, 0); __builtin_amdgcn_s_setprio(0); } while (0)
#define PG8_WAIT_V(n) asm volatile("s_waitcnt vmcnt(" #n ")" ::: "memory")
#define PG8_WAIT_L(n) asm volatile("s_waitcnt lgkmcnt(" #n ")" ::: "memory")
#define PG8_BAR __builtin_amdgcn_s_barrier()
#define PG8_SCHED __builtin_amdgcn_sched_barrier(0)
    Unit cur, nxt; int ui = 0;
    if (!S.next(0, cur)) return;
    f32x4 acc[2][2][4][2];
#pragma unroll
    for (int a = 0; a < 2; ++a)
#pragma unroll
        for (int b = 0; b < 2; ++b)
#pragma unroll
            for (int m = 0; m < 4; ++m)
#pragma unroll
                for (int n = 0; n < 2; ++n) acc[a][b][m][n] = (f32x4){0.f, 0.f, 0.f, 0.f};
    bf16x8 At[4][2], B0[2][2], B1[2][2];
    const char* cA = (const char*)g.A + (size_t)cur.pm * tstep; const char* cB = (const char*)g.Bt + (size_t)cur.pn * tstep;
    S.a_ready(cur);
    if constexpr (SP2) {
        PG8_STAGE(PG8_SB(0, 0), cB, voffB); PG8_STAGE(PG8_SB(0, 1), cB + hstep, voffB); PG8_STAGE(PG8_SA(0, 0), cA, voffA); PG8_STAGE(PG8_SA(0, 1), cA + hstep, voffA);
        if (wr == 1) PG8_BAR;
        PG8_WAIT_V(2); PG8_BAR;
        PG8_STAGE(PG8_SB(1, 0), cB + kstep, voffB); PG8_STAGE(PG8_SA(1, 0), cA + kstep, voffA); PG8_STAGE(PG8_SB(1, 1), cB + hstep + kstep, voffB);
        PG8_WAIT_V(6); PG8_BAR;
    } else {
        PG8_STAGE(PG8_SB(0, 0), cB, voffB); PG8_STAGE(PG8_SA(0, 0), cA, voffA); PG8_STAGE(PG8_SB(0, 1), cB + hstep, voffB); PG8_STAGE(PG8_SA(0, 1), cA + hstep, voffA);
        if (wr == 1) PG8_BAR;
        PG8_WAIT_V(4); PG8_BAR;
        PG8_STAGE(PG8_SB(1, 0), cB + kstep, voffB); PG8_STAGE(PG8_SA(1, 0), cA + kstep, voffA); PG8_STAGE(PG8_SB(1, 1), cB + hstep + kstep, voffB);
        PG8_WAIT_V(6); PG8_BAR;
    }
    for (;;) {
        const bool has_next = S.next(ui + 1, nxt);
        const char* nA = has_next ? (const char*)g.A + (size_t)nxt.pm * tstep : cA; const char* nB = has_next ? (const char*)g.Bt + (size_t)nxt.pn * tstep : cB;
        for (int t = 0; t < nt; t += 2) {
            const bool last = (t == nt - 2);
            const char* a1 = cA + (size_t)(t + 1) * kstep;
            const char* a2 = last ? nA : cA + (size_t)(t + 2) * kstep; const char* b2 = last ? nB : cB + (size_t)(t + 2) * kstep;
            const char* a3 = a2 + kstep; const char* b3 = b2 + kstep;
            if (last && has_next) S.a_ready(nxt);
            if constexpr (SP2) {
            PG8_LDB(B0, 0, 0); PG8_LDB(B1, 0, 1); PG8_SCHED; PG8_LDA(At, 0, 0); PG8_STAGE(PG8_SA(1, 1), a1 + hstep, voffA);
            PG8_WAIT_V(8); PG8_WAIT_L(0); PG8_BAR; PG8_MMA(0, 0, At, B0); PG8_MMA(0, 1, At, B1); PG8_BAR; PG8_SCHED;
            PG8_LDA(At, 0, 1); PG8_STAGE(PG8_SB(0, 0), b2, voffB); PG8_STAGE(PG8_SB(0, 1), b2 + hstep, voffB); PG8_STAGE(PG8_SA(0, 0), a2, voffA);
            PG8_WAIT_V(8); PG8_WAIT_L(0); PG8_BAR; PG8_MMA(1, 0, At, B0); PG8_MMA(1, 1, At, B1); PG8_BAR; PG8_SCHED;
            PG8_LDB(B0, 1, 0); PG8_LDB(B1, 1, 1); PG8_SCHED; PG8_LDA(At, 1, 0); PG8_STAGE(PG8_SA(0, 1), a2 + hstep, voffA);
            PG8_WAIT_V(8); PG8_WAIT_L(0); PG8_BAR; PG8_MMA(0, 0, At, B0); PG8_MMA(0, 1, At, B1); PG8_BAR; PG8_SCHED;
            PG8_LDA(At, 1, 1); PG8_STAGE(PG8_SB(1, 0), b3, voffB); PG8_STAGE(PG8_SB(1, 1), b3 + hstep, voffB); PG8_STAGE(PG8_SA(1, 0), a3, voffA);
            PG8_WAIT_V(8); PG8_WAIT_L(0); PG8_BAR; PG8_MMA(1, 0, At, B0); PG8_MMA(1, 1, At, B1); PG8_BAR; PG8_SCHED;
            } else {
            PG8_LDB(B0, 0, 0); PG8_SCHED; PG8_LDA(At, 0, 0); PG8_STAGE(PG8_SA(1, 1), a1 + hstep, voffA);
            PG8_WAIT_L(8); PG8_BAR; PG8_WAIT_L(0); PG8_MMA(0, 0, At, B0); PG8_BAR; PG8_SCHED;
            PG8_LDB(B1, 0, 1); PG8_STAGE(PG8_SB(0, 0), b2, voffB);
            PG8_BAR; PG8_WAIT_L(0); PG8_MMA(0, 1, At, B1); PG8_BAR;
            PG8_LDA(At, 0, 1); PG8_STAGE(PG8_SA(0, 0), a2, voffA);
            PG8_BAR; PG8_WAIT_L(0); PG8_MMA(1, 0, At, B0); PG8_BAR; PG8_SCHED;
            PG8_STAGE(PG8_SB(0, 1), b2 + hstep, voffB);
            PG8_WAIT_V(6); PG8_BAR; PG8_MMA(1, 1, At, B1); PG8_BAR;
            PG8_LDB(B0, 1, 0); PG8_SCHED; PG8_LDA(At, 1, 0); PG8_STAGE(PG8_SA(0, 1), a2 + hstep, voffA);
            PG8_WAIT_L(8); PG8_BAR; PG8_WAIT_L(0); PG8_MMA(0, 0, At, B0); PG8_BAR; PG8_SCHED;
            PG8_LDB(B1, 1, 1); PG8_STAGE(PG8_SB(1, 0), b3, voffB);
            PG8_BAR; PG8_WAIT_L(0); PG8_MMA(0, 1, At, B1); PG8_BAR;
            PG8_LDA(At, 1, 1); PG8_STAGE(PG8_SA(1, 0), a3, voffA);
            PG8_BAR; PG8_WAIT_L(0); PG8_MMA(1, 0, At, B0); PG8_BAR; PG8_SCHED;
            PG8_STAGE(PG8_SB(1, 1), b3 + hstep, voffB);
            PG8_WAIT_V(6); PG8_BAR; PG8_MMA(1, 1, At, B1); PG8_BAR;
            }
        }
        if constexpr (ALIGN_EPI) { if (wr == 0) PG8_BAR; }
        if constexpr (!Epi::AFTER_DRAIN) { E(acc, cur, wr, wc, fr, fq); S.done(cur); }
        if (!has_next) break;
#pragma unroll
        for (int a = 0; a < 2; ++a)
#pragma unroll
            for (int b = 0; b < 2; ++b)
#pragma unroll
                for (int m = 0; m < 4; ++m)
#pragma unroll
                    for (int n = 0; n < 2; ++n) acc[a][b][m][n] = (f32x4){0.f, 0.f, 0.f, 0.f};
        cur = nxt; cA = nA; cB = nB; ++ui;
        if constexpr (ALIGN_EPI) { if (wr == 1) PG8_BAR; }
    }
    PG8_WAIT_V(0);
    if constexpr (!ALIGN_EPI) { if (wr == 0) PG8_BAR; }
    PG8_BAR;
    if constexpr (Epi::AFTER_DRAIN) { E.fused(acc, cur, wr, wc, fr, fq, lds, wid, lane); S.done(cur); }
#undef PG8_SA
#undef PG8_SB
#undef PG8_STAGE
#undef PG8_LDA
#undef PG8_LDB
#undef PG8_MMA
#undef PG8_WAIT_V
#undef PG8_WAIT_L
#undef PG8_BAR
#undef PG8_SCHED
}
}

#ifndef PG8_SP2
#define PG8_SP2 true
#endif
#ifndef PG8_ALIGN
#define PG8_ALIGN true
#endif
constexpr int NWAVES = 8;
constexpr int NPH = 9;
#ifndef MK_N_LAUNCHES
#define MK_N_LAUNCHES 9
#endif
constexpr int N_LAUNCHES = MK_N_LAUNCHES;
static_assert(N_LAUNCHES == 1 || N_LAUNCHES == NPH, "MK_N_LAUNCHES is 1 or NPH");

constexpr int BATCH = 8, T = 8192, D = 1024, M = BATCH * T;
constexpr int INC = 4624, NIN = 4608;
constexpr int FF = 2816, NGU = 2 * FF, MIXW = 2048, XBC = 1536;
constexpr int PC_LX = 0, PC_LG = 1024, PC_Z = 2048, PC_X = 3072, PC_B = 4096, PC_C = 4352;
constexpr float EPS = 1e-6f;

constexpr size_t MiB = 1u << 20;
constexpr size_t WS_CTL = 0, CTL_ZERO_BYTES = 1 * MiB;
constexpr size_t WS_WIN = 2 * MiB, WS_WOUT = 11 * MiB, WS_WGU = 15 * MiB, WS_WD = 26 * MiB;
constexpr size_t WS_DTV = 32 * MiB;
constexpr size_t WS_PART = 36 * MiB;
constexpr size_t WS_PROJ = 64 * MiB;
constexpr size_t WS_XN = 640 * MiB;
constexpr size_t WS_YMIX = 768 * MiB;
constexpr size_t WS_HID = 64 * MiB;
constexpr size_t WS_MIXF = 416 * MiB;
constexpr size_t WS_END = 1024 * MiB;
static_assert(WS_WIN + (size_t)NIN * D * 2 <= WS_WOUT && WS_WOUT + (size_t)D * MIXW * 2 <= WS_WGU && WS_WGU + (size_t)NGU * D * 2 <= WS_WD && WS_WD + (size_t)D * FF * 2 <= WS_DTV, "weights map");
static_assert(WS_DTV + (size_t)M * 16 * 4 <= WS_PART && WS_PART + (size_t)M * 32 * 4 <= WS_PROJ && WS_PROJ + (size_t)M * NIN * 2 <= WS_XN && WS_XN + (size_t)M * D * 2 <= WS_YMIX && WS_YMIX + (size_t)M * MIXW * 2 <= WS_END, "d_ws map");
static_assert(WS_HID + (size_t)M * FF * 2 <= WS_MIXF && WS_MIXF + (size_t)M * D * 2 <= WS_XN, "overlay map");
constexpr int CW_TMO = 0, CW_CODE = 1;
constexpr int CW_BAR = 4096;

constexpr int RING_OFF = 0, RING_BYTES = 131072;
constexpr int LDSCTL_OFF = RING_BYTES, MISC_OFF = LDSCTL_OFF + 320;
constexpr int LDS_BYTES = 147456;
static_assert(MISC_OFF + 128 <= LDS_BYTES, "LDS map");
#define GAS __attribute__((address_space(1)))
#define LAS __attribute__((address_space(3)))
typedef unsigned short bf16;
typedef unsigned v4u __attribute__((ext_vector_type(4)));
typedef float f32x4 __attribute__((ext_vector_type(4)));
typedef short bf16x8 __attribute__((ext_vector_type(8)));
typedef GAS unsigned gu32;
typedef GAS unsigned long long gu64;
#define RLX_AGENT __ATOMIC_RELAXED, __HIP_MEMORY_SCOPE_AGENT
#define LDS_WAIT() asm volatile("s_waitcnt lgkmcnt(0)" ::: "memory")
#define VM_WAIT() asm volatile("s_waitcnt vmcnt(0)" ::: "memory")
__device__ __forceinline__ unsigned long long rt() { return __builtin_amdgcn_s_memrealtime(); }
__device__ __forceinline__ unsigned f2bf(float f) { unsigned u = __builtin_bit_cast(unsigned, f); return (u + 0x7fffu + ((u >> 16) & 1u)) >> 16; }
__device__ __forceinline__ unsigned pk2(float lo, float hi) { return f2bf(lo) | (f2bf(hi) << 16); }

#define XB_TMO      128
#define XB_XCNT(j)  (256  + 64 * (j))
#define XB_XSUB(j)  (1280 + 64 * (j))
#define XB_XGEN(j)  (2304 + 64 * (j))
#define XB_TOP      3328
#define XB_TOPGEN   3392
#define XCD_BAR_WORDS 3456
#define XB_SPIN_CAP (1u << 18)

__device__ __forceinline__ unsigned xb_ld(unsigned* p)              { return __hip_atomic_load(p, __ATOMIC_RELAXED, __HIP_MEMORY_SCOPE_AGENT); }
__device__ __forceinline__ unsigned xb_add(unsigned* p, unsigned v) { return __hip_atomic_fetch_add(p, v, __ATOMIC_RELAXED, __HIP_MEMORY_SCOPE_AGENT); }
__device__ __forceinline__ unsigned xb_xcc_id() { return (unsigned)__builtin_amdgcn_s_getreg((3 << 11) | 20) & 0xFu; }
#define XB_SPIN(cond, bar) do { unsigned _sp = 0; while (cond) { __builtin_amdgcn_s_sleep(1); \
    if ((++_sp & 255u) == 0u) { if (xb_ld(&(bar)[XB_TMO])) break; if (_sp > XB_SPIN_CAP) { atomicAdd(&(bar)[XB_TMO], 1u); break; } } } } while (0)

struct XcdBarrier {
    unsigned* bar; unsigned x;
    volatile LAS unsigned* st;
};

__device__ __forceinline__ XcdBarrier xcd_barrier_post(unsigned* bar, volatile LAS unsigned* st) {
    XcdBarrier b; b.bar = bar; b.x = xb_xcc_id(); b.st = st;
    if (threadIdx.x == 0) (void)xb_add(&bar[XB_XCNT(b.x)], 1u);
    return b;
}
__device__ __forceinline__ void xcd_barrier_complete(unsigned* bar, unsigned x, unsigned& nloc, unsigned& nx) {
    const unsigned G = gridDim.x * gridDim.y * gridDim.z;
    unsigned sum, cnt, mine, sp = 0u;
    for (;;) {
        sum = 0u; cnt = 0u; mine = 0u;
#pragma unroll
        for (unsigned j = 0; j < 16; ++j) { const unsigned c = xb_ld(&bar[XB_XCNT(j)]); sum += c; cnt += (c > 0u) ? 1u : 0u; mine = (j == x) ? c : mine; }
        if (sum == G) break;
        __builtin_amdgcn_s_sleep(1);
        if ((++sp & 255u) == 0u) { if (xb_ld(&bar[XB_TMO])) break; if (sp > XB_SPIN_CAP) { atomicAdd(&bar[XB_TMO], 1u); break; } }
    }
    nloc = mine > 0u ? mine : 1u; nx = cnt > 0u ? cnt : 1u;
}

__device__ __forceinline__ void xcd_barrier(const XcdBarrier& b) {
    asm volatile("s_waitcnt vmcnt(0)" ::: "memory");
    __syncthreads();
    if (threadIdx.x == 0) {
        unsigned* bar = b.bar;
        __builtin_amdgcn_s_waitcnt(0);
        unsigned nloc = b.st[0], nx = b.st[1];
        if (nloc == 0u) { xcd_barrier_complete(bar, b.x, nloc, nx); b.st[0] = nloc; b.st[1] = nx; }
        const unsigned old = xb_add(&bar[XB_XSUB(b.x)], 1u);
        const unsigned gen = old / nloc;
        if (old + 1u == (gen + 1u) * nloc) {
            __builtin_amdgcn_fence(__ATOMIC_RELEASE, "agent");
            asm volatile("s_waitcnt vmcnt(0)" ::: "memory");
            const unsigned og = xb_add(&bar[XB_TOP], 1u);
            const unsigned tg = og / nx;
            if (og + 1u == (tg + 1u) * nx) xb_add(&bar[XB_TOPGEN], 1u);
            else XB_SPIN(xb_ld(&bar[XB_TOPGEN]) == tg, bar);
            __builtin_amdgcn_fence(__ATOMIC_ACQUIRE, "agent");
            xb_add(&bar[XB_XGEN(b.x)], 1u);
            asm volatile("s_waitcnt vmcnt(0)" ::: "memory");
        } else {
            XB_SPIN(xb_ld(&bar[XB_XGEN(b.x)]) == gen, bar);
            __builtin_amdgcn_fence(__ATOMIC_ACQUIRE, "agent");
            asm volatile("s_waitcnt vmcnt(0)" ::: "memory");
        }
    }
    __syncthreads();
}

struct Frame {
    LAS unsigned char* lds;
    volatile LAS unsigned* MISC;
    gu32* ctl;
    int tid, lane, wave;
    int vcu, G;
    const float* const* in; float* out; unsigned char* ws;
};
#define F_x        (F.in[0])
#define F_g_pre    (F.in[1])
#define F_w_in     (F.in[2])
#define F_lru_cw   (F.in[3])
#define F_lru_cb   (F.in[4])
#define F_lru_wa   (F.in[5])
#define F_lru_ba   (F.in[6])
#define F_lru_wx   (F.in[7])
#define F_lru_bx   (F.in[8])
#define F_lru_lam  (F.in[9])
#define F_g_lru    (F.in[10])
#define F_ssd_cw   (F.in[11])
#define F_ssd_cb   (F.in[12])
#define F_ssd_dtb  (F.in[13])
#define F_ssd_alog (F.in[14])
#define F_ssd_d    (F.in[15])
#define F_g_ssd    (F.in[16])
#define F_w_out    (F.in[17])
#define F_g_pm     (F.in[18])
#define F_g_pf     (F.in[19])
#define F_w_gate   (F.in[20])
#define F_w_up     (F.in[21])
#define F_w_down   (F.in[22])
#define F_g_post   (F.in[23])
#define F_Win_t  ((bf16*)(F.ws + WS_WIN))
#define F_Wout_t ((bf16*)(F.ws + WS_WOUT))
#define F_Wgu_t  ((bf16*)(F.ws + WS_WGU))
#define F_Wd_t   ((bf16*)(F.ws + WS_WD))
#define F_PROJ   ((bf16*)(F.ws + WS_PROJ))
#define F_XN     ((bf16*)(F.ws + WS_XN))
#define F_YMIX   ((bf16*)(F.ws + WS_YMIX))
#define F_HID    ((bf16*)(F.ws + WS_HID))
#define F_MIXF   ((bf16*)(F.ws + WS_MIXF))
#define F_DTV    ((float*)(F.ws + WS_DTV))
#define F_PART   ((float*)(F.ws + WS_PART))

__device__ __forceinline__ float wave_sum(float v) {
#pragma unroll
    for (int o = 1; o < 64; o <<= 1) v += __shfl_xor(v, o);
    return v;
}
__device__ __forceinline__ float bf2f(bf16 h) { return __builtin_bit_cast(float, (unsigned)h << 16); }
__device__ __forceinline__ float bflo(unsigned w) { return __builtin_bit_cast(float, w << 16); }
__device__ __forceinline__ float bfhi(unsigned w) { return __builtin_bit_cast(float, w & 0xffff0000u); }
__device__ __forceinline__ float sigmoidf_(float v) { return 1.0f / (1.0f + expf(-v)); }
__device__ __forceinline__ float siluf_(float v) { return v / (1.0f + expf(-v)); }
__device__ __forceinline__ float softplusf_(float v) { return fmaxf(v, 0.f) + log1pf(expf(-fabsf(v))); }
__device__ __forceinline__ float gelu_tanhf_(float v) { const float c = 0.7978845608028654f; return 0.5f * v * (1.0f + tanhf(c * (v + 0.044715f * v * v * v))); }

__device__ __forceinline__ void p0_transpose_item(const float* W, int ldw, int Kdst, int k0, int n0, bf16* WT, int drow0, LAS float* scr, int lane) {
#pragma unroll 8
    for (int i = 0; i < 32; ++i) { const int kk = 2 * i + (lane >> 5); scr[kk * 33 + (lane & 31)] = W[(size_t)(k0 + kk) * ldw + n0 + (lane & 31)]; }
    LDS_WAIT(); asm volatile("" ::: "memory");
    const int c = lane & 7;
#pragma unroll
    for (int j = 0; j < 4; ++j) { const int n = (lane >> 3) + 8 * j; const LAS float* s = scr + (8 * c) * 33 + n;
        v4u o; o.x = pk2(s[0 * 33], s[1 * 33]); o.y = pk2(s[2 * 33], s[3 * 33]); o.z = pk2(s[4 * 33], s[5 * 33]); o.w = pk2(s[6 * 33], s[7 * 33]);
        *(GAS v4u*)(WT + (size_t)(drow0 + n) * Kdst + k0 + 8 * c) = o; }
    LDS_WAIT(); asm volatile("" ::: "memory");
}
__device__ __forceinline__ void p0_prologue(Frame& F) {
    LAS float* scr = (LAS float*)(F.lds + RING_OFF + F.wave * 16384);
    const int gw = F.vcu * NWAVES + F.wave, NGW = F.G * NWAVES;
    constexpr int I_IN = (D / 64) * (NIN / 32), I_OUT = (MIXW / 64) * (D / 32), I_G = (D / 64) * (FF / 32), I_D = (FF / 64) * (D / 32);
    constexpr int NITEMS = I_IN + I_OUT + 2 * I_G + I_D;
    for (int it = gw; it < NITEMS; it += NGW) {
        int r = it;
        if (r < I_IN) { const int nb = r % (NIN / 32), kb = r / (NIN / 32); p0_transpose_item(F_w_in, INC, D, 64 * kb, 32 * nb, F_Win_t, 32 * nb, scr, F.lane); continue; } r -= I_IN;
        if (r < I_OUT) { const int nb = r % (D / 32), kb = r / (D / 32); p0_transpose_item(F_w_out, D, MIXW, 64 * kb, 32 * nb, F_Wout_t, 32 * nb, scr, F.lane); continue; } r -= I_OUT;
        if (r < I_G) { const int nb = r % (FF / 32), kb = r / (FF / 32), n0 = 32 * nb; p0_transpose_item(F_w_gate, FF, D, 64 * kb, n0, F_Wgu_t, 256 * (n0 >> 7) + (n0 & 127), scr, F.lane); continue; } r -= I_G;
        if (r < I_G) { const int nb = r % (FF / 32), kb = r / (FF / 32), n0 = 32 * nb; p0_transpose_item(F_w_up, FF, D, 64 * kb, n0, F_Wgu_t, 256 * (n0 >> 7) + 128 + (n0 & 127), scr, F.lane); continue; } r -= I_G;
        { const int nb = r % (D / 32), kb = r / (D / 32); p0_transpose_item(F_w_down, D, FF, 64 * kb, 32 * nb, F_Wd_t, 32 * nb, scr, F.lane); }
    }
    __syncthreads();
    LAS f32x4* tbl = (LAS f32x4*)(F.lds + RING_OFF);
    for (int e = F.tid; e < 4096; e += NWAVES * 64) { const int l = e & 63, hq = (e >> 6) & 3, ci = e >> 8; const int col = 4 * l + 256 * (ci >> 2) + (ci & 3);
        const float* src = F_w_in + (size_t)col * INC + NIN + hq * 4; tbl[e] = (f32x4){src[0], src[1], src[2], src[3]}; }
    __syncthreads();
    f32x4 g[4];
#pragma unroll
    for (int j = 0; j < 4; ++j) g[j] = *(const f32x4*)(F_g_pre + 4 * F.lane + 256 * j);
    const float dtb = F_ssd_dtb[F.lane & 15];
    for (int r0 = gw * 4; r0 < M; r0 += NGW * 4) {
        f32x4 xv[4][4];
#pragma unroll
        for (int rr = 0; rr < 4; ++rr) {
            const float* xr = F_x + (size_t)(r0 + rr) * D + 4 * F.lane; float ss = 0.f;
#pragma unroll
            for (int j = 0; j < 4; ++j) { xv[rr][j] = *(const f32x4*)(xr + 256 * j); ss += (xv[rr][j].x * xv[rr][j].x + xv[rr][j].y * xv[rr][j].y) + (xv[rr][j].z * xv[rr][j].z + xv[rr][j].w * xv[rr][j].w); }
            const float rstd = 1.0f / sqrtf(wave_sum(ss) * (1.0f / D) + EPS);
            GAS unsigned long long* o8 = (GAS unsigned long long*)(F_XN + (size_t)(r0 + rr) * D) + F.lane;
#pragma unroll
            for (int j = 0; j < 4; ++j) { xv[rr][j] = xv[rr][j] * rstd * g[j];
                o8[64 * j] = (unsigned long long)pk2(xv[rr][j].x, xv[rr][j].y) | ((unsigned long long)pk2(xv[rr][j].z, xv[rr][j].w) << 32); }
        }
        float v[64];
#pragma unroll
        for (int i = 0; i < 64; ++i) v[i] = 0.f;
#pragma unroll
        for (int j = 0; j < 4; ++j)
#pragma unroll
            for (int e = 0; e < 4; ++e)
#pragma unroll
                for (int hq = 0; hq < 4; ++hq) { const f32x4 w = tbl[((j * 4 + e) * 4 + hq) * 64 + F.lane];
#pragma unroll
                    for (int rr = 0; rr < 4; ++rr) { const float xe = xv[rr][j][e];
                        v[rr * 16 + hq * 4 + 0] += xe * w.x; v[rr * 16 + hq * 4 + 1] += xe * w.y; v[rr * 16 + hq * 4 + 2] += xe * w.z; v[rr * 16 + hq * 4 + 3] += xe * w.w; }
                    if (hq == 3) asm volatile("" ::: "memory"); }
#pragma unroll
        for (int half = 32; half >= 1; half >>= 1) { const bool up = (F.lane & half) != 0;
#pragma unroll
            for (int i = 0; i < half; ++i) { const float send = up ? v[i] : v[i + half]; const float keep = up ? v[i + half] : v[i]; v[i] = keep + __shfl_xor(send, half); } }
        F_DTV[(size_t)(r0 + (F.lane >> 4)) * 16 + (F.lane & 15)] = softplusf_(v[0] + dtb);
    }
}

__device__ __forceinline__ void lru_baseline_unit(Frame& F, int unit) {
    const int b = unit >> 4, blk = unit & 15, lane = F.lane, ch = blk * 64 + lane;
    LAS float* wl = (LAS float*)(F.lds + RING_OFF);
#pragma unroll 8
    for (int i = 0; i < 64; ++i) { wl[i * 64 + lane] = F_lru_wa[blk * 4096 + i * 64 + lane]; wl[4096 + i * 64 + lane] = F_lru_wx[blk * 4096 + i * 64 + lane]; }
    LDS_WAIT(); asm volatile("" ::: "memory");
    const float ba = F_lru_ba[ch], bx = F_lru_bx[ch], sp = softplusf_(-F_lru_lam[ch]);
    const float c0 = F_lru_cw[ch], c1 = F_lru_cw[1024 + ch], c2 = F_lru_cw[2048 + ch], c3 = F_lru_cw[3072 + ch], cb = F_lru_cb[ch];
    float xm3 = 0.f, xm2 = 0.f, xm1 = 0.f, h = 0.f;
    const bf16* px = F_PROJ + (size_t)(b * T) * NIN + PC_LX + ch; const bf16* pg = F_PROJ + (size_t)(b * T) * NIN + PC_LG + ch;
    for (int t0 = 0; t0 < T; t0 += 8) {
        float xr[8], gr[8];
#pragma unroll
        for (int j = 0; j < 8; ++j) { xr[j] = bf2f(px[(size_t)(t0 + j) * NIN]); gr[j] = bf2f(pg[(size_t)(t0 + j) * NIN]); }
#pragma unroll
        for (int j = 0; j < 8; ++j) {
            const float x0 = xr[j]; const float lx = cb + c0 * xm3 + c1 * xm2 + c2 * xm1 + c3 * x0; xm3 = xm2; xm2 = xm1; xm1 = x0;
            float rp = ba, ip = bx;
#pragma unroll
            for (int i = 0; i < 64; ++i) { const float s = __builtin_bit_cast(float, __builtin_amdgcn_readlane(__builtin_bit_cast(int, lx), i)); rp = fmaf(s, wl[i * 64 + lane], rp); ip = fmaf(s, wl[4096 + i * 64 + lane], ip); }
            const float r = sigmoidf_(rp), ig = sigmoidf_(ip), la = -8.0f * r * sp, a = expf(la), mult = sqrtf(-expm1f(2.0f * la));
            h = a * h + mult * (ig * lx);
            const float y = h * gelu_tanhf_(gr[j]);
            const float ss = wave_sum(y * y);
            const size_t row = (size_t)(b * T + t0 + j);
            F_YMIX[row * MIXW + ch] = (bf16)f2bf(y);
            if (lane == 0) F_PART[row * 32 + blk] = ss;
        }
    }
}
__device__ __forceinline__ float ssd_convsilu(Frame& F, int b, int t, int c) {
    float acc = F_ssd_cb[c];
#pragma unroll
    for (int k = 0; k < 4; ++k) { const int tk = t - 3 + k; if (tk >= 0) acc += F_ssd_cw[k * XBC + c] * bf2f(F_PROJ[(size_t)(b * T + tk) * NIN + PC_X + c]); }
    return siluf_(acc);
}
__device__ __forceinline__ void ssd_baseline_unit(Frame& F, int unit) {
    const int b = unit >> 4, h = unit & 15, g = h >> 3, tid = F.tid, p = tid >> 3, nq = tid & 7;
    LAS float* Bs = (LAS float*)(F.lds + RING_OFF);
    LAS float* Cs = Bs + 32 * 128;
    LAS float* xs = Cs + 32 * 128;
    LAS float* zs = xs + 32 * 64;
    LAS float* yb = zs + 32 * 64;
    LAS float* dts = yb + 32 * 64;
    const float A = -expf(F_ssd_alog[h]), Dh = F_ssd_d[h];
    float S[16];
#pragma unroll
    for (int i = 0; i < 16; ++i) S[i] = 0.f;
    for (int t0 = 0; t0 < T; t0 += 32) {
        for (int e = tid; e < 32 * 128; e += NWAVES * 64) { const int tt = e >> 7, n = e & 127;
            Bs[e] = ssd_convsilu(F, b, t0 + tt, 1024 + g * 128 + n); Cs[e] = ssd_convsilu(F, b, t0 + tt, 1280 + g * 128 + n); }
        for (int e = tid; e < 32 * 64; e += NWAVES * 64) { const int tt = e >> 6, pp = e & 63;
            xs[e] = ssd_convsilu(F, b, t0 + tt, h * 64 + pp); zs[e] = bf2f(F_PROJ[(size_t)(b * T + t0 + tt) * NIN + PC_Z + h * 64 + pp]); }
        if (tid < 32) dts[tid] = F_DTV[(size_t)(b * T + t0 + tid) * 16 + h];
        __syncthreads();
        for (int tt = 0; tt < 32; ++tt) {
            const float dtv = dts[tt], da = expf(dtv * A), xv = xs[tt * 64 + p], dtx = dtv * xv; float yp = 0.f;
#pragma unroll
            for (int i = 0; i < 16; ++i) { const float Bv = Bs[tt * 128 + nq * 16 + i], Cv = Cs[tt * 128 + nq * 16 + i]; S[i] = S[i] * da + dtx * Bv; yp += Cv * S[i]; }
            yp += __shfl_xor(yp, 1); yp += __shfl_xor(yp, 2); yp += __shfl_xor(yp, 4);
            if (nq == 0) { const float z = zs[tt * 64 + p]; yb[tt * 64 + p] = (yp + Dh * xv) * siluf_(z); }
        }
        __syncthreads();
        for (int e = tid; e < 32 * 64; e += NWAVES * 64) { const int tt = e >> 6, pp = e & 63; F_YMIX[(size_t)(b * T + t0 + tt) * MIXW + 1024 + h * 64 + pp] = (bf16)f2bf(yb[e]); }
#pragma unroll
        for (int r = 0; r < 4; ++r) { const int tt = 4 * F.wave + r; const float v = yb[tt * 64 + F.lane]; const float ss = wave_sum(v * v);
            if (F.lane == 0) F_PART[(size_t)(b * T + t0 + tt) * 32 + 16 + h] = ss; }
        __syncthreads();
    }
}
__device__ __forceinline__ void p2_mixer_baseline(Frame& F) {
    const int j = (int)blockIdx.x;
    for (int u = j; u < 256; u += F.G) {
        if (u < 128) ssd_baseline_unit(F, u);
        else if (F.wave == 0) lru_baseline_unit(F, u - 128);
        __syncthreads();
    }
}
__device__ __forceinline__ void p3_ymix_norm(Frame& F) {
    const int gw = F.vcu * NWAVES + F.wave, NGW = F.G * NWAVES, lane = F.lane;
    float gn[4][8];
#pragma unroll
    for (int j = 0; j < 4; ++j)
#pragma unroll
        for (int e = 0; e < 8; ++e) { const int c = 8 * lane + 512 * j + e; gn[j][e] = (j < 2) ? F_g_lru[c] : F_g_ssd[c - 1024]; }
    for (int row = gw; row < M; row += NGW) {
        float s = F_PART[(size_t)row * 32 + (lane & 31)];
        s += __shfl_xor(s, 1); s += __shfl_xor(s, 2); s += __shfl_xor(s, 4); s += __shfl_xor(s, 8);
        const float sl = __shfl(s, 0), ssd = __shfl(s, 16);
        const float rl = 1.0f / sqrtf(sl * (1.0f / 1024.0f) + EPS), rs = 1.0f / sqrtf(ssd * (1.0f / 1024.0f) + EPS);
        GAS v4u* yp = (GAS v4u*)(F_YMIX + (size_t)row * MIXW) + lane;
#pragma unroll
        for (int j = 0; j < 4; ++j) { const v4u w = yp[64 * j]; const float sc = (j < 2) ? rl : rs; v4u o;
            o.x = pk2(bflo(w.x) * sc * gn[j][0], bfhi(w.x) * sc * gn[j][1]); o.y = pk2(bflo(w.y) * sc * gn[j][2], bfhi(w.y) * sc * gn[j][3]);
            o.z = pk2(bflo(w.z) * sc * gn[j][4], bfhi(w.z) * sc * gn[j][5]); o.w = pk2(bflo(w.w) * sc * gn[j][6], bfhi(w.w) * sc * gn[j][7]);
            yp[64 * j] = o; }
    }
}
__device__ __forceinline__ void p5_post_mix(Frame& F) {
    const int gw = F.vcu * NWAVES + F.wave, NGW = F.G * NWAVES, lane = F.lane;
    f32x4 gm[4], gf[4];
#pragma unroll
    for (int j = 0; j < 4; ++j) { gm[j] = *(const f32x4*)(F_g_pm + 4 * lane + 256 * j); gf[j] = *(const f32x4*)(F_g_pf + 4 * lane + 256 * j); }
    for (int row = gw; row < M; row += NGW) {
        const GAS unsigned long long* mp = (const GAS unsigned long long*)(F_MIXF + (size_t)row * D) + lane;
        const GAS f32x4* xp = (const GAS f32x4*)(F_x + (size_t)row * D) + lane;
        f32x4 mv[4], xv[4]; float ss = 0.f;
#pragma unroll
        for (int j = 0; j < 4; ++j) { const unsigned long long w = mp[64 * j]; const unsigned lo = (unsigned)w, hi = (unsigned)(w >> 32);
            mv[j] = (f32x4){bflo(lo), bfhi(lo), bflo(hi), bfhi(hi)}; xv[j] = xp[64 * j];
            ss += (mv[j].x * mv[j].x + mv[j].y * mv[j].y) + (mv[j].z * mv[j].z + mv[j].w * mv[j].w); }
        const float rm = 1.0f / sqrtf(wave_sum(ss) * (1.0f / D) + EPS);
        float s1 = 0.f;
        GAS f32x4* op = (GAS f32x4*)(F.out + (size_t)row * D) + lane;
#pragma unroll
        for (int j = 0; j < 4; ++j) { xv[j] = xv[j] + mv[j] * rm * gm[j]; op[64 * j] = xv[j];
            s1 += (xv[j].x * xv[j].x + xv[j].y * xv[j].y) + (xv[j].z * xv[j].z + xv[j].w * xv[j].w); }
        const float r1 = 1.0f / sqrtf(wave_sum(s1) * (1.0f / D) + EPS);
        GAS unsigned long long* hp = (GAS unsigned long long*)(F_XN + (size_t)row * D) + lane;
#pragma unroll
        for (int j = 0; j < 4; ++j) { const f32x4 hv = xv[j] * r1 * gf[j]; hp[64 * j] = (unsigned long long)pk2(hv.x, hv.y) | ((unsigned long long)pk2(hv.z, hv.w) << 32); }
    }
}
__device__ __forceinline__ void p8_post_ffn(Frame& F) {
    const int gw = F.vcu * NWAVES + F.wave, NGW = F.G * NWAVES, lane = F.lane;
    f32x4 gp[4];
#pragma unroll
    for (int j = 0; j < 4; ++j) gp[j] = *(const f32x4*)(F_g_post + 4 * lane + 256 * j);
    for (int row = gw; row < M; row += NGW) {
        const GAS unsigned long long* mp = (const GAS unsigned long long*)(F_MIXF + (size_t)row * D) + lane;
        GAS f32x4* op = (GAS f32x4*)(F.out + (size_t)row * D) + lane;
        f32x4 mv[4], xv[4]; float ss = 0.f;
#pragma unroll
        for (int j = 0; j < 4; ++j) { const unsigned long long w = mp[64 * j]; const unsigned lo = (unsigned)w, hi = (unsigned)(w >> 32);
            mv[j] = (f32x4){bflo(lo), bfhi(lo), bflo(hi), bfhi(hi)}; xv[j] = op[64 * j];
            ss += (mv[j].x * mv[j].x + mv[j].y * mv[j].y) + (mv[j].z * mv[j].z + mv[j].w * mv[j].w); }
        const float rm = 1.0f / sqrtf(wave_sum(ss) * (1.0f / D) + EPS);
#pragma unroll
        for (int j = 0; j < 4; ++j) op[64 * j] = xv[j] + mv[j] * rm * gp[j];
    }
}

struct Args { const float* in[24]; float* out; unsigned char* ws; int ph_lo, ph_hi, li, pad; };
__global__ void __launch_bounds__(NWAVES * 64, 2) hyb_fwd(Args args) {
    extern __shared__ __attribute__((aligned(16))) unsigned char lds[];
    Frame F;
    F.lds = (LAS unsigned char*)lds;
    F.MISC = (volatile LAS unsigned*)(F.lds + MISC_OFF);
    F.tid = threadIdx.x; F.lane = F.tid & 63; F.wave = __builtin_amdgcn_readfirstlane(F.tid >> 6);
    F.G = gridDim.x; { const int bx = blockIdx.x; F.vcu = (F.G % 8 == 0) ? (bx % 8) * (F.G / 8) + bx / 8 : bx; }
    unsigned char* ws = args.ws;
    F.ctl = (gu32*)(ws + WS_CTL);
    F.in = args.in; F.out = args.out; F.ws = ws;
    for (int u = F.tid; u < (LDS_BYTES - LDSCTL_OFF) / 4; u += NWAVES * 64) ((LAS unsigned*)(F.lds + LDSCTL_OFF))[u] = 0u;
    __syncthreads();
    XcdBarrier bar; bar.bar = (unsigned*)(F.ctl + CW_BAR); bar.x = 0; bar.st = nullptr;
    if (N_LAUNCHES == 1) bar = xcd_barrier_post((unsigned*)(F.ctl + CW_BAR), F.MISC + 8);
#define GRID_BAR() do { if (N_LAUNCHES == 1) xcd_barrier(bar); } while (0)
    const int lo = args.ph_lo, hi = args.ph_hi;
#ifndef PHMASK
#define PHMASK 0x1ff
#endif
#define IN(k) (((PHMASK >> (k)) & 1) && lo <= (k) && (k) < hi)
#define BOTH(k) (IN(k) && IN((k) + 1))

    if (IN(0)) { p0_prologue(F); if (BOTH(0)) GRID_BAR(); }
    if (IN(1)) {
        pg8::Gemm g{F_XN, F_Win_t, M, NIN, D}; pg8::StaticOrder S; S.init(M, NIN, F.G, (int)blockIdx.x);
        pg8::EpiBf16<0> E{F_PROJ, NIN, nullptr, 0, 0, 1.f};
        pg8::gemm_phase<pg8::EpiBf16<0>, pg8::StaticOrder, PG8_ALIGN, PG8_SP2>(F.lds + RING_OFF, g, S, E);
        if (BOTH(1)) GRID_BAR();
    }
    if (IN(2)) { p2_mixer_baseline(F); if (BOTH(2)) GRID_BAR(); }
    if (IN(3)) { p3_ymix_norm(F); if (BOTH(3)) GRID_BAR(); }
    if (IN(4)) {
        pg8::Gemm g{F_YMIX, F_Wout_t, M, D, MIXW}; pg8::StaticOrder S; S.init(M, D, F.G, (int)blockIdx.x);
        pg8::EpiBf16<0> E{F_MIXF, D, nullptr, 0, 0, 1.f};
        pg8::gemm_phase<pg8::EpiBf16<0>, pg8::StaticOrder, PG8_ALIGN, PG8_SP2>(F.lds + RING_OFF, g, S, E);
        if (BOTH(4)) GRID_BAR();
    }
    if (IN(5)) { p5_post_mix(F); if (BOTH(5)) GRID_BAR(); }
    if (IN(6)) {
        pg8::Gemm g{F_XN, F_Wgu_t, M, NGU, D}; pg8::StaticOrder S; S.init(M, NGU, F.G, (int)blockIdx.x);
        pg8::EpiSwiGLU E{F_HID, FF};
        pg8::gemm_phase<pg8::EpiSwiGLU, pg8::StaticOrder, PG8_ALIGN, PG8_SP2>(F.lds + RING_OFF, g, S, E);
        if (BOTH(6)) GRID_BAR();
    }
    if (IN(7)) {
        pg8::Gemm g{F_HID, F_Wd_t, M, D, FF}; pg8::StaticOrder S; S.init(M, D, F.G, (int)blockIdx.x);
        pg8::EpiBf16<0> E{F_MIXF, D, nullptr, 0, 0, 1.f};
        pg8::gemm_phase<pg8::EpiBf16<0>, pg8::StaticOrder, PG8_ALIGN, PG8_SP2>(F.lds + RING_OFF, g, S, E);
        if (BOTH(7)) GRID_BAR();
    }
    if (IN(8)) { p8_post_ffn(F); }
#undef IN
#undef BOTH
}

extern "C" void kernel_launch(void* const* d_in, const int* in_sizes, int n_in, void* d_out, int out_size, void* d_ws, size_t ws_size, hipStream_t stream) {
    static int grid = 0;
    if (grid == 0) {
        if (n_in != 24 || in_sizes[0] != M * D || out_size != M * D || ws_size < WS_END) { fprintf(stderr, "kernel_launch: unexpected shapes: n_in %d in0 %d out %d ws %zu\n", n_in, n_in > 0 ? in_sizes[0] : -1, out_size, ws_size); grid = -1; return; }
        int dev = 0, cus = 0, per_cu = 0;
        if (hipGetDevice(&dev) != hipSuccess || hipDeviceGetAttribute(&cus, hipDeviceAttributeMultiprocessorCount, dev) != hipSuccess) { grid = -1; return; }
        if (hipFuncSetAttribute((const void*)hyb_fwd, hipFuncAttributeMaxDynamicSharedMemorySize, LDS_BYTES) != hipSuccess) { fprintf(stderr, "kernel_launch: hipFuncSetAttribute failed\n"); grid = -1; return; }
        if (hipOccupancyMaxActiveBlocksPerMultiprocessor(&per_cu, (const void*)hyb_fwd, NWAVES * 64, LDS_BYTES) != hipSuccess || per_cu < 1) { fprintf(stderr, "kernel_launch: occupancy query says %d blocks per CU\n", per_cu); (void)hipGetLastError(); grid = -1; return; }
        grid = cus;
    }
    if (grid < 0) return;
    (void)hipMemsetAsync((char*)d_ws + WS_CTL, 0, CTL_ZERO_BYTES, stream);
    Args a{};
    for (int i = 0; i < 24; ++i) a.in[i] = (const float*)d_in[i];
    a.out = (float*)d_out; a.ws = (unsigned char*)d_ws;
    for (int li = 0; li < N_LAUNCHES; ++li) {
        a.ph_lo = (N_LAUNCHES == NPH) ? li : 0; a.ph_hi = (N_LAUNCHES == NPH) ? li + 1 : NPH; a.li = li;
        hipLaunchKernelGGL(hyb_fwd, dim3(grid), dim3(NWAVES * 64), LDS_BYTES, stream, a);
    }
}
```

```cpp
#include <hip/hip_runtime.h>
#include <cstdio>
#include <cstdint>
namespace pg8 {
#define PG8_LAS __attribute__((address_space(3)))
typedef unsigned short bf16_t;
typedef short bf16x8 __attribute__((ext_vector_type(8)));
typedef float f32x4 __attribute__((ext_vector_type(4)));
typedef unsigned u32x4 __attribute__((ext_vector_type(4)));
constexpr int BM = 256, BK = 64, HALF = 128, HTB = HALF * BK * 2  , STAGE_BYTES = 8 * HTB, NXCD = 8, WGM = 8;

__host__ __device__ __forceinline__ int lds_byte(int r, int c) { const int st = (r >> 4) * 2 + (c >> 5), rr = r & 15, cc = c & 31, ob = rr * 64 + cc * 2; return st * 1024 + (ob ^ (((ob >> 9) & 1) << 5)); }
__host__ __device__ __forceinline__ void stage_rc(int b, int& R, int& C) { const int st = b / 1024, sb = b % 1024, swz = sb ^ (((sb >> 9) & 1) << 5); R = (st >> 1) * 16 + swz / 64; C = (st & 1) * 32 + (swz % 64) / 2; }
__host__ __device__ __forceinline__ int perm32(int rho) { const int n = rho >> 4, i = rho & 15; return 8 * (i >> 2) + 4 * n + (i & 3); }

struct Unit { int pm, pn; };
struct Gemm { const bf16_t* A; const bf16_t* Bt; int M, N, K; };

struct StaticOrder {
    int nM, nN, nwg, G, c;
    __host__ __device__ void init(int M, int N, int G_, int c_) { nM = M / BM; nN = N / BM; nwg = nM * nN; G = G_; c = c_; }
    __host__ __device__ bool next(int i, Unit& u) const {
        const long L = (long)i * G + c; if (L >= nwg) return false;
        int wgid = (int)L; { const int q = nwg / NXCD, r = nwg % NXCD, xcd = wgid % NXCD, off = wgid / NXCD; wgid = (xcd < r ? xcd * (q + 1) : r * (q + 1) + (xcd - r) * q) + off; }
        const int nig = WGM * nN, gid = wgid / nig, fm = gid * WGM, gsz = (nM - fm) < WGM ? (nM - fm) : WGM;
        u.pm = fm + ((wgid % nig) % gsz); u.pn = (wgid % nig) / gsz; return true;
    }
    __device__ __forceinline__ void a_ready(const Unit&) const {}
    __device__ __forceinline__ void done(const Unit&) const {}
};

__device__ __forceinline__ unsigned cvt_pk_bf16(float lo, float hi) { unsigned r; asm volatile("v_cvt_pk_bf16_f32 %0, %1, %2" : "=v"(r) : "v"(lo), "v"(hi)); return r; }
typedef float f32x2 __attribute__((ext_vector_type(2)));
__device__ __forceinline__ f32x2 gelu_pk(f32x2 v) {
    const f32x2 av = __builtin_elementwise_abs(v), d = av * 0.2316418882f + 1.0f;
    f32x2 t; t.x = __builtin_amdgcn_rcpf(d.x); t.y = __builtin_amdgcn_rcpf(d.y);
    f32x2 q = t * 0.5307027145f + (-0.7265760135f); q = q * t + 0.7107068705f; q = q * t + (-0.142248368f); q = q * t + 0.127414796f; q = q * t;
    const f32x2 s = (v * v) * (-0.72134752044f);
    f32x2 e; e.x = __builtin_amdgcn_exp2f(s.x); e.y = __builtin_amdgcn_exp2f(s.y);
    const f32x2 m = v * (q * e), r = v - m;
    f32x2 o; o.x = v.x < 0.f ? m.x : r.x; o.y = v.y < 0.f ? m.y : r.y; return o;
}

template <int ACT  > struct EpiBf16 {
    static constexpr bool PERM = true, AFTER_DRAIN = false; static_assert(ACT == 0 || ACT == 1, "EpiBf16: ACT is 0 (none) or 1 (gelu_pk)");
    bf16_t* O; int ldc; const float* bias; int split_cols; size_t split_stride; float scale0;
    __device__ __forceinline__ void operator()(const f32x4 (&acc)[2][2][4][2], const Unit& u, int wr, int wc, int fr, int fq) const {
        const int row0 = u.pm * BM + wr * 64 + fr; int colt = u.pn * BM; bf16_t* base = O;
        float sc = 1.f; if (split_cols) { const int t = colt / split_cols; base += (size_t)t * split_stride; colt -= t * split_cols; if (t == 0) sc = scale0; }
        const int col0 = colt + wc * 32 + 8 * fq, bcol0 = u.pn * BM + wc * 32 + 8 * fq;
        f32x4 bv[2][2];
#pragma unroll
        for (int bj = 0; bj < 2; ++bj)
#pragma unroll
            for (int n = 0; n < 2; ++n) bv[bj][n] = bias ? *(const f32x4*)(bias + bcol0 + bj * HALF + 4 * n) : (f32x4){0.f, 0.f, 0.f, 0.f};
#pragma unroll
        for (int ai = 0; ai < 2; ++ai)
#pragma unroll
            for (int m = 0; m < 4; ++m) { bf16_t* rowp = base + (size_t)(row0 + ai * HALF + m * 16) * ldc + col0;
#pragma unroll
                for (int bj = 0; bj < 2; ++bj) { f32x4 v0 = acc[ai][bj][m][0] + bv[bj][0], v1 = acc[ai][bj][m][1] + bv[bj][1];
                    if (ACT == 1) { f32x2 a = gelu_pk((f32x2){v0[0], v0[1]}), b = gelu_pk((f32x2){v0[2], v0[3]}), c = gelu_pk((f32x2){v1[0], v1[1]}), d = gelu_pk((f32x2){v1[2], v1[3]});
                        v0 = (f32x4){a.x, a.y, b.x, b.y}; v1 = (f32x4){c.x, c.y, d.x, d.y}; }
                    v0 = v0 * sc; v1 = v1 * sc; u32x4 w; w.x = cvt_pk_bf16(v0[0], v0[1]); w.y = cvt_pk_bf16(v0[2], v0[3]); w.z = cvt_pk_bf16(v1[0], v1[1]); w.w = cvt_pk_bf16(v1[2], v1[3]);
                    *(u32x4*)(rowp + bj * HALF) = w; } }
    }
};
struct EpiSwiGLU {
    static constexpr bool PERM = true, AFTER_DRAIN = false;
    bf16_t* O; int ldc;
    __device__ __forceinline__ static float silu_mul(float g, float u) { return g * __builtin_amdgcn_rcpf(1.0f + __expf(-g)) * u; }
    __device__ __forceinline__ void operator()(const f32x4 (&acc)[2][2][4][2], const Unit& u, int wr, int wc, int fr, int fq) const {
        const int row0 = u.pm * BM + wr * 64 + fr; const int col0 = u.pn * HALF + wc * 32 + 8 * fq;
#pragma unroll
        for (int ai = 0; ai < 2; ++ai)
#pragma unroll
            for (int m = 0; m < 4; ++m) { bf16_t* rowp = O + (size_t)(row0 + ai * HALF + m * 16) * ldc + col0;
                const f32x4 g0 = acc[ai][0][m][0], g1 = acc[ai][0][m][1], u0 = acc[ai][1][m][0], u1 = acc[ai][1][m][1];
                u32x4 w; w.x = cvt_pk_bf16(silu_mul(g0[0], u0[0]), silu_mul(g0[1], u0[1])); w.y = cvt_pk_bf16(silu_mul(g0[2], u0[2]), silu_mul(g0[3], u0[3]));
                w.z = cvt_pk_bf16(silu_mul(g1[0], u1[0]), silu_mul(g1[1], u1[1])); w.w = cvt_pk_bf16(silu_mul(g1[2], u1[2]), silu_mul(g1[3], u1[3]));
                *(u32x4*)rowp = w; }
    }
};

template <class Epi, class Sched, bool ALIGN_EPI = false, bool SP2 = false>
__device__ __forceinline__ void gemm_phase(PG8_LAS unsigned char* lds, const Gemm g, const Sched& S, const Epi& E) {
    const int tid = threadIdx.x, wid = __builtin_amdgcn_readfirstlane(tid >> 6), lane = tid & 63, wr = wid >> 2, wc = wid & 3, fr = lane & 15, fq = lane >> 4;
    const int K = g.K, nt = K / BK;
    unsigned voffA[2], voffB[2];
#pragma unroll
    for (int i = 0; i < 2; ++i) { int R, C; stage_rc(tid * 16 + i * 8192, R, C); const int Rb = Epi::PERM ? ((R & ~31) + perm32(R & 31)) : R;
        voffA[i] = (unsigned)(R * K + C) * 2u; voffB[i] = (unsigned)(Rb * K + C) * 2u; }
    const size_t kstep = (size_t)(BK * 2);
    const size_t hstep = (size_t)HALF * K * 2;
    const size_t tstep = 2 * hstep;
    const unsigned ldsw = (unsigned)wid * 1024u;
    const int aoff = lds_byte(wr * 64 + fr, fq * 8), boff = lds_byte(wc * 32 + fr, fq * 8);
#define PG8_SA(b, h) (((b) * 2 + (h)) * HTB)
#define PG8_SB(b, h) ((4 + (b) * 2 + (h)) * HTB)
#define PG8_STAGE(bufoff, gbase, voff) do { _Pragma("unroll") for (int _i = 0; _i < 2; ++_i) \
        __builtin_amdgcn_global_load_lds((const unsigned*)((const char*)(gbase) + (voff)[_i]), (PG8_LAS unsigned*)(lds + (bufoff) + ldsw + _i * 8192), 16, 0, 0); } while (0)
#define PG8_LDA(dst, b, h) do { _Pragma("unroll") for (int m = 0; m < 4; ++m) _Pragma("unroll") for (int k = 0; k < 2; ++k) dst[m][k] = *(const PG8_LAS bf16x8*)(lds + PG8_SA(b, h) + aoff + m * 2048 + k * 1024); } while (0)
#define PG8_LDB(dst, b, h) do { _Pragma("unroll") for (int n = 0; n < 2; ++n) _Pragma("unroll") for (int k = 0; k < 2; ++k) dst[n][k] = *(const PG8_LAS bf16x8*)(lds + PG8_SB(b, h) + boff + n * 2048 + k * 1024); } while (0)
#define PG8_MMA(ai, bj, At, Bt) do { __builtin_amdgcn_s_setprio(1); _Pragma("unroll") for (int m = 0; m < 4; ++m) _Pragma("unroll") for (int n = 0; n < 2; ++n) _Pragma("unroll") for (int k = 0; k < 2; ++k) \
        acc[ai][bj][m][n] = __builtin_amdgcn_mfma_f32_16x16x32_bf16(Bt[n][k], At[m][k], acc[ai][bj][m][n], 0, 0, 0); __builtin_amdgcn_s_setprio(0); } while (0)
#define PG8_WAIT_V(n) asm volatile("s_waitcnt vmcnt(" #n ")" ::: "memory")
#define PG8_WAIT_L(n) asm volatile("s_waitcnt lgkmcnt(" #n ")" ::: "memory")
#define PG8_BAR __builtin_amdgcn_s_barrier()
#define PG8_SCHED __builtin_amdgcn_sched_barrier(0)
    Unit cur, nxt; int ui = 0;
    if (!S.next(0, cur)) return;
    f32x4 acc[2][2][4][2];
#pragma unroll
    for (int a = 0; a < 2; ++a)
#pragma unroll
        for (int b = 0; b < 2; ++b)
#pragma unroll
            for (int m = 0; m < 4; ++m)
#pragma unroll
                for (int n = 0; n < 2; ++n) acc[a][b][m][n] = (f32x4){0.f, 0.f, 0.f, 0.f};
    bf16x8 At[4][2], B0[2][2], B1[2][2];
    const char* cA = (const char*)g.A + (size_t)cur.pm * tstep; const char* cB = (const char*)g.Bt + (size_t)cur.pn * tstep;
    S.a_ready(cur);
    if constexpr (SP2) {
        PG8_STAGE(PG8_SB(0, 0), cB, voffB); PG8_STAGE(PG8_SB(0, 1), cB + hstep, voffB); PG8_STAGE(PG8_SA(0, 0), cA, voffA); PG8_STAGE(PG8_SA(0, 1), cA + hstep, voffA);
        if (wr == 1) PG8_BAR;
        PG8_WAIT_V(2); PG8_BAR;
        PG8_STAGE(PG8_SB(1, 0), cB + kstep, voffB); PG8_STAGE(PG8_SA(1, 0), cA + kstep, voffA); PG8_STAGE(PG8_SB(1, 1), cB + hstep + kstep, voffB);
        PG8_WAIT_V(6); PG8_BAR;
    } else {
        PG8_STAGE(PG8_SB(0, 0), cB, voffB); PG8_STAGE(PG8_SA(0, 0), cA, voffA); PG8_STAGE(PG8_SB(0, 1), cB + hstep, voffB); PG8_STAGE(PG8_SA(0, 1), cA + hstep, voffA);
        if (wr == 1) PG8_BAR;
        PG8_WAIT_V(4); PG8_BAR;
        PG8_STAGE(PG8_SB(1, 0), cB + kstep, voffB); PG8_STAGE(PG8_SA(1, 0), cA + kstep, voffA); PG8_STAGE(PG8_SB(1, 1), cB + hstep + kstep, voffB);
        PG8_WAIT_V(6); PG8_BAR;
    }
    for (;;) {
        const bool has_next = S.next(ui + 1, nxt);
        const char* nA = has_next ? (const char*)g.A + (size_t)nxt.pm * tstep : cA; const char* nB = has_next ? (const char*)g.Bt + (size_t)nxt.pn * tstep : cB;
        for (int t = 0; t < nt; t += 2) {
            const bool last = (t == nt - 2);
            const char* a1 = cA + (size_t)(t + 1) * kstep;
            const char* a2 = last ? nA : cA + (size_t)(t + 2) * kstep; const char* b2 = last ? nB : cB + (size_t)(t + 2) * kstep;
            const char* a3 = a2 + kstep; const char* b3 = b2 + kstep;
            if (last && has_next) S.a_ready(nxt);
            if constexpr (SP2) {
            PG8_LDB(B0, 0, 0); PG8_LDB(B1, 0, 1); PG8_SCHED; PG8_LDA(At, 0, 0); PG8_STAGE(PG8_SA(1, 1), a1 + hstep, voffA);
            PG8_WAIT_V(8); PG8_WAIT_L(0); PG8_BAR; PG8_MMA(0, 0, At, B0); PG8_MMA(0, 1, At, B1); PG8_BAR; PG8_SCHED;
            PG8_LDA(At, 0, 1); PG8_STAGE(PG8_SB(0, 0), b2, voffB); PG8_STAGE(PG8_SB(0, 1), b2 + hstep, voffB); PG8_STAGE(PG8_SA(0, 0), a2, voffA);
            PG8_WAIT_V(8); PG8_WAIT_L(0); PG8_BAR; PG8_MMA(1, 0, At, B0); PG8_MMA(1, 1, At, B1); PG8_BAR; PG8_SCHED;
            PG8_LDB(B0, 1, 0); PG8_LDB(B1, 1, 1); PG8_SCHED; PG8_LDA(At, 1, 0); PG8_STAGE(PG8_SA(0, 1), a2 + hstep, voffA);
            PG8_WAIT_V(8); PG8_WAIT_L(0); PG8_BAR; PG8_MMA(0, 0, At, B0); PG8_MMA(0, 1, At, B1); PG8_BAR; PG8_SCHED;
            PG8_LDA(At, 1, 1); PG8_STAGE(PG8_SB(1, 0), b3, voffB); PG8_STAGE(PG8_SB(1, 1), b3 + hstep, voffB); PG8_STAGE(PG8_SA(1, 0), a3, voffA);
            PG8_WAIT_V(8); PG8_WAIT_L(0); PG8_BAR; PG8_MMA(1, 0, At, B0); PG8_MMA(1, 1, At, B1); PG8_BAR; PG8_SCHED;
            } else {
            PG8_LDB(B0, 0, 0); PG8_SCHED; PG8_LDA(At, 0, 0); PG8_STAGE(PG8_SA(1, 1), a1 + hstep, voffA);
            PG8_WAIT_L(8); PG8_BAR; PG8_WAIT_L(0); PG8_MMA(0, 0, At, B0); PG8_BAR; PG8_SCHED;
            PG8_LDB(B1, 0, 1); PG8_STAGE(PG8_SB(0, 0), b2, voffB);
            PG8_BAR; PG8_WAIT_L(0); PG8_MMA(0, 1, At, B1); PG8_BAR;
            PG8_LDA(At, 0, 1); PG8_STAGE(PG8_SA(0, 0), a2, voffA);
            PG8_BAR; PG8_WAIT_L(0); PG8_MMA(1, 0, At, B0); PG8_BAR; PG8_SCHED;
            PG8_STAGE(PG8_SB(0, 1), b2 + hstep, voffB);
            PG8_WAIT_V(6); PG8_BAR; PG8_MMA(1, 1, At, B1); PG8_BAR;
            PG8_LDB(B0, 1, 0); PG8_SCHED; PG8_LDA(At, 1, 0); PG8_STAGE(PG8_SA(0, 1), a2 + hstep, voffA);
            PG8_WAIT_L(8); PG8_BAR; PG8_WAIT_L(0); PG8_MMA(0, 0, At, B0); PG8_BAR; PG8_SCHED;
            PG8_LDB(B1, 1, 1); PG8_STAGE(PG8_SB(1, 0), b3, voffB);
            PG8_BAR; PG8_WAIT_L(0); PG8_MMA(0, 1, At, B1); PG8_BAR;
            PG8_LDA(At, 1, 1); PG8_STAGE(PG8_SA(1, 0), a3, voffA);
            PG8_BAR; PG8_WAIT_L(0); PG8_MMA(1, 0, At, B0); PG8_BAR; PG8_SCHED;
            PG8_STAGE(PG8_SB(1, 1), b3 + hstep, voffB);
            PG8_WAIT_V(6); PG8_BAR; PG8_MMA(1, 1, At, B1); PG8_BAR;
            }
        }
        if constexpr (ALIGN_EPI) { if (wr == 0) PG8_BAR; }
        if constexpr (!Epi::AFTER_DRAIN) { E(acc, cur, wr, wc, fr, fq); S.done(cur); }
        if (!has_next) break;
#pragma unroll
        for (int a = 0; a < 2; ++a)
#pragma unroll
            for (int b = 0; b < 2; ++b)
#pragma unroll
                for (int m = 0; m < 4; ++m)
#pragma unroll
                    for (int n = 0; n < 2; ++n) acc[a][b][m][n] = (f32x4){0.f, 0.f, 0.f, 0.f};
        cur = nxt; cA = nA; cB = nB; ++ui;
        if constexpr (ALIGN_EPI) { if (wr == 1) PG8_BAR; }
    }
    PG8_WAIT_V(0);
    if constexpr (!ALIGN_EPI) { if (wr == 0) PG8_BAR; }
    PG8_BAR;
    if constexpr (Epi::AFTER_DRAIN) { E.fused(acc, cur, wr, wc, fr, fq, lds, wid, lane); S.done(cur); }
#undef PG8_SA
#undef PG8_SB
#undef PG8_STAGE
#undef PG8_LDA
#undef PG8_LDB
#undef PG8_MMA
#undef PG8_WAIT_V
#undef PG8_WAIT_L
#undef PG8_BAR
#undef PG8_SCHED
}
}

#ifndef PG8_SP2
#define PG8_SP2 true
#endif
#ifndef PG8_ALIGN
#define PG8_ALIGN true
#endif
constexpr int NWAVES = 8;
constexpr int NPH = 9;
#ifndef MK_N_LAUNCHES
#define MK_N_LAUNCHES 1
#endif
constexpr int N_LAUNCHES = MK_N_LAUNCHES;
static_assert(N_LAUNCHES == 1 || N_LAUNCHES == NPH, "MK_N_LAUNCHES is 1 or NPH");

constexpr int BATCH = 8, T = 8192, D = 1024, M = BATCH * T;
constexpr int INC = 4624, NIN = 4608;
constexpr int FF = 2816, NGU = 2 * FF, MIXW = 2048, XBC = 1536;
constexpr int PC_LX = 0, PC_LG = 1024, PC_Z = 2048, PC_X = 3072, PC_B = 4096, PC_C = 4352;
constexpr float EPS = 1e-6f;

constexpr size_t MiB = 1u << 20;
constexpr size_t WS_CTL = 0, CTL_ZERO_BYTES = 1 * MiB;
constexpr size_t WS_WIN = 2 * MiB, WS_WOUT = 11 * MiB, WS_WGU = 15 * MiB, WS_WD = 26 * MiB;
constexpr size_t WS_DTV = 32 * MiB;
constexpr size_t WS_PART = 36 * MiB;
constexpr size_t WS_PROJ = 64 * MiB;
constexpr size_t WS_XN = 640 * MiB;
constexpr size_t WS_YMIX = 768 * MiB;
constexpr size_t WS_HID = 64 * MiB;
constexpr size_t WS_MIXF = 416 * MiB;
constexpr size_t WS_END = 1024 * MiB;
static_assert(WS_WIN + (size_t)NIN * D * 2 <= WS_WOUT && WS_WOUT + (size_t)D * MIXW * 2 <= WS_WGU && WS_WGU + (size_t)NGU * D * 2 <= WS_WD && WS_WD + (size_t)D * FF * 2 <= WS_DTV, "weights map");
static_assert(WS_DTV + (size_t)M * 16 * 4 <= WS_PART && WS_PART + (size_t)M * 32 * 4 <= WS_PROJ && WS_PROJ + (size_t)M * NIN * 2 <= WS_XN && WS_XN + (size_t)M * D * 2 <= WS_YMIX && WS_YMIX + (size_t)M * MIXW * 2 <= WS_END, "d_ws map");
static_assert(WS_HID + (size_t)M * FF * 2 <= WS_MIXF && WS_MIXF + (size_t)M * D * 2 <= WS_XN, "overlay map");
constexpr int CW_TMO = 0, CW_CODE = 1;
constexpr int CW_BAR = 4096;

constexpr int RING_OFF = 0, RING_BYTES = 131072;
constexpr int LDSCTL_OFF = RING_BYTES, MISC_OFF = LDSCTL_OFF + 320;
constexpr int LDS_BYTES = 147456;
static_assert(MISC_OFF + 128 <= LDS_BYTES, "LDS map");
#define GAS __attribute__((address_space(1)))
#define LAS __attribute__((address_space(3)))
typedef unsigned short bf16;
typedef unsigned v4u __attribute__((ext_vector_type(4)));
typedef float f32x4 __attribute__((ext_vector_type(4)));
typedef short bf16x8 __attribute__((ext_vector_type(8)));
typedef GAS unsigned gu32;
typedef GAS unsigned long long gu64;
#define RLX_AGENT __ATOMIC_RELAXED, __HIP_MEMORY_SCOPE_AGENT
#define LDS_WAIT() asm volatile("s_waitcnt lgkmcnt(0)" ::: "memory")
#define VM_WAIT() asm volatile("s_waitcnt vmcnt(0)" ::: "memory")
__device__ __forceinline__ unsigned long long rt() { return __builtin_amdgcn_s_memrealtime(); }
__device__ __forceinline__ unsigned f2bf(float f) { unsigned u = __builtin_bit_cast(unsigned, f); return (u + 0x7fffu + ((u >> 16) & 1u)) >> 16; }
__device__ __forceinline__ unsigned pk2(float lo, float hi) { return f2bf(lo) | (f2bf(hi) << 16); }

#define XB_TMO      128
#define XB_XCNT(j)  (256  + 64 * (j))
#define XB_XSUB(j)  (1280 + 64 * (j))
#define XB_XGEN(j)  (2304 + 64 * (j))
#define XB_TOP      3328
#define XB_TOPGEN   3392
#define XCD_BAR_WORDS 3456
#define XB_SPIN_CAP (1u << 18)

__device__ __forceinline__ unsigned xb_ld(unsigned* p)              { return __hip_atomic_load(p, __ATOMIC_RELAXED, __HIP_MEMORY_SCOPE_AGENT); }
__device__ __forceinline__ unsigned xb_add(unsigned* p, unsigned v) { return __hip_atomic_fetch_add(p, v, __ATOMIC_RELAXED, __HIP_MEMORY_SCOPE_AGENT); }
__device__ __forceinline__ unsigned xb_xcc_id() { return (unsigned)__builtin_amdgcn_s_getreg((3 << 11) | 20) & 0xFu; }
#define XB_SPIN(cond, bar) do { unsigned _sp = 0; while (cond) { __builtin_amdgcn_s_sleep(1); \
    if ((++_sp & 255u) == 0u) { if (xb_ld(&(bar)[XB_TMO])) break; if (_sp > XB_SPIN_CAP) { atomicAdd(&(bar)[XB_TMO], 1u); break; } } } } while (0)

struct XcdBarrier {
    unsigned* bar; unsigned x;
    volatile LAS unsigned* st;
};

__device__ __forceinline__ XcdBarrier xcd_barrier_post(unsigned* bar, volatile LAS unsigned* st) {
    XcdBarrier b; b.bar = bar; b.x = xb_xcc_id(); b.st = st;
    if (threadIdx.x == 0) (void)xb_add(&bar[XB_XCNT(b.x)], 1u);
    return b;
}
__device__ __forceinline__ void xcd_barrier_complete(unsigned* bar, unsigned x, unsigned& nloc, unsigned& nx) {
    const unsigned G = gridDim.x * gridDim.y * gridDim.z;
    unsigned sum, cnt, mine, sp = 0u;
    for (;;) {
        sum = 0u; cnt = 0u; mine = 0u;
#pragma unroll
        for (unsigned j = 0; j < 16; ++j) { const unsigned c = xb_ld(&bar[XB_XCNT(j)]); sum += c; cnt += (c > 0u) ? 1u : 0u; mine = (j == x) ? c : mine; }
        if (sum == G) break;
        __builtin_amdgcn_s_sleep(1);
        if ((++sp & 255u) == 0u) { if (xb_ld(&bar[XB_TMO])) break; if (sp > XB_SPIN_CAP) { atomicAdd(&bar[XB_TMO], 1u); break; } }
    }
    nloc = mine > 0u ? mine : 1u; nx = cnt > 0u ? cnt : 1u;
}

__device__ __forceinline__ void xcd_barrier(const XcdBarrier& b) {
    asm volatile("s_waitcnt vmcnt(0)" ::: "memory");
    __syncthreads();
    if (threadIdx.x == 0) {
        unsigned* bar = b.bar;
        __builtin_amdgcn_s_waitcnt(0);
        unsigned nloc = b.st[0], nx = b.st[1];
        if (nloc == 0u) { xcd_barrier_complete(bar, b.x, nloc, nx); b.st[0] = nloc; b.st[1] = nx; }
        const unsigned old = xb_add(&bar[XB_XSUB(b.x)], 1u);
        const unsigned gen = old / nloc;
        if (old + 1u == (gen + 1u) * nloc) {
            __builtin_amdgcn_fence(__ATOMIC_RELEASE, "agent");
            asm volatile("s_waitcnt vmcnt(0)" ::: "memory");
            const unsigned og = xb_add(&bar[XB_TOP], 1u);
            const unsigned tg = og / nx;
            if (og + 1u == (tg + 1u) * nx) xb_add(&bar[XB_TOPGEN], 1u);
            else XB_SPIN(xb_ld(&bar[XB_TOPGEN]) == tg, bar);
            __builtin_amdgcn_fence(__ATOMIC_ACQUIRE, "agent");
            xb_add(&bar[XB_XGEN(b.x)], 1u);
            asm volatile("s_waitcnt vmcnt(0)" ::: "memory");
        } else {
            XB_SPIN(xb_ld(&bar[XB_XGEN(b.x)]) == gen, bar);
            __builtin_amdgcn_fence(__ATOMIC_ACQUIRE, "agent");
            asm volatile("s_waitcnt vmcnt(0)" ::: "memory");
        }
    }
    __syncthreads();
}

struct Frame {
    LAS unsigned char* lds;
    volatile LAS unsigned* MISC;
    gu32* ctl;
    int tid, lane, wave;
    int vcu, G;
    const float* const* in; float* out; unsigned char* ws;
};
#define F_x        (F.in[0])
#define F_g_pre    (F.in[1])
#define F_w_in     (F.in[2])
#define F_lru_cw   (F.in[3])
#define F_lru_cb   (F.in[4])
#define F_lru_wa   (F.in[5])
#define F_lru_ba   (F.in[6])
#define F_lru_wx   (F.in[7])
#define F_lru_bx   (F.in[8])
#define F_lru_lam  (F.in[9])
#define F_g_lru    (F.in[10])
#define F_ssd_cw   (F.in[11])
#define F_ssd_cb   (F.in[12])
#define F_ssd_dtb  (F.in[13])
#define F_ssd_alog (F.in[14])
#define F_ssd_d    (F.in[15])
#define F_g_ssd    (F.in[16])
#define F_w_out    (F.in[17])
#define F_g_pm     (F.in[18])
#define F_g_pf     (F.in[19])
#define F_w_gate   (F.in[20])
#define F_w_up     (F.in[21])
#define F_w_down   (F.in[22])
#define F_g_post   (F.in[23])
#define F_Win_t  ((bf16*)(F.ws + WS_WIN))
#define F_Wout_t ((bf16*)(F.ws + WS_WOUT))
#define F_Wgu_t  ((bf16*)(F.ws + WS_WGU))
#define F_Wd_t   ((bf16*)(F.ws + WS_WD))
#define F_PROJ   ((bf16*)(F.ws + WS_PROJ))
#define F_XN     ((bf16*)(F.ws + WS_XN))
#define F_YMIX   ((bf16*)(F.ws + WS_YMIX))
#define F_HID    ((bf16*)(F.ws + WS_HID))
#define F_MIXF   ((bf16*)(F.ws + WS_MIXF))
#define F_DTV    ((float*)(F.ws + WS_DTV))
#define F_PART   ((float*)(F.ws + WS_PART))

__device__ __forceinline__ float wave_sum(float v) {
#pragma unroll
    for (int o = 1; o < 64; o <<= 1) v += __shfl_xor(v, o);
    return v;
}
__device__ __forceinline__ float bf2f(bf16 h) { return __builtin_bit_cast(float, (unsigned)h << 16); }
__device__ __forceinline__ float bflo(unsigned w) { return __builtin_bit_cast(float, w << 16); }
__device__ __forceinline__ float bfhi(unsigned w) { return __builtin_bit_cast(float, w & 0xffff0000u); }
__device__ __forceinline__ float sigmoidf_(float v) { return 1.0f / (1.0f + expf(-v)); }
__device__ __forceinline__ float siluf_(float v) { return v / (1.0f + expf(-v)); }
__device__ __forceinline__ float softplusf_(float v) { return fmaxf(v, 0.f) + log1pf(expf(-fabsf(v))); }
__device__ __forceinline__ float gelu_tanhf_(float v) { const float c = 0.7978845608028654f; return 0.5f * v * (1.0f + tanhf(c * (v + 0.044715f * v * v * v))); }

__device__ __forceinline__ void p0_transpose_item(const float* W, int ldw, int Kdst, int k0, int n0, bf16* WT, int drow0, LAS float* scr, int lane) {
#pragma unroll 8
    for (int i = 0; i < 32; ++i) { const int kk = 2 * i + (lane >> 5); scr[kk * 33 + (lane & 31)] = W[(size_t)(k0 + kk) * ldw + n0 + (lane & 31)]; }
    LDS_WAIT(); asm volatile("" ::: "memory");
    const int c = lane & 7;
#pragma unroll
    for (int j = 0; j < 4; ++j) { const int n = (lane >> 3) + 8 * j; const LAS float* s = scr + (8 * c) * 33 + n;
        v4u o; o.x = pk2(s[0 * 33], s[1 * 33]); o.y = pk2(s[2 * 33], s[3 * 33]); o.z = pk2(s[4 * 33], s[5 * 33]); o.w = pk2(s[6 * 33], s[7 * 33]);
        *(GAS v4u*)(WT + (size_t)(drow0 + n) * Kdst + k0 + 8 * c) = o; }
    LDS_WAIT(); asm volatile("" ::: "memory");
}
__device__ __forceinline__ void p0_prologue(Frame& F) {
    LAS float* scr = (LAS float*)(F.lds + RING_OFF + F.wave * 16384);
    const int gw = F.vcu * NWAVES + F.wave, NGW = F.G * NWAVES;
    constexpr int I_IN = (D / 64) * (NIN / 32), I_OUT = (MIXW / 64) * (D / 32), I_G = (D / 64) * (FF / 32), I_D = (FF / 64) * (D / 32);
    constexpr int NITEMS = I_IN + I_OUT + 2 * I_G + I_D;
    for (int it = gw; it < NITEMS; it += NGW) {
        int r = it;
        if (r < I_IN) { const int nb = r % (NIN / 32), kb = r / (NIN / 32); p0_transpose_item(F_w_in, INC, D, 64 * kb, 32 * nb, F_Win_t, 32 * nb, scr, F.lane); continue; } r -= I_IN;
        if (r < I_OUT) { const int nb = r % (D / 32), kb = r / (D / 32); p0_transpose_item(F_w_out, D, MIXW, 64 * kb, 32 * nb, F_Wout_t, 32 * nb, scr, F.lane); continue; } r -= I_OUT;
        if (r < I_G) { const int nb = r % (FF / 32), kb = r / (FF / 32), n0 = 32 * nb; p0_transpose_item(F_w_gate, FF, D, 64 * kb, n0, F_Wgu_t, 256 * (n0 >> 7) + (n0 & 127), scr, F.lane); continue; } r -= I_G;
        if (r < I_G) { const int nb = r % (FF / 32), kb = r / (FF / 32), n0 = 32 * nb; p0_transpose_item(F_w_up, FF, D, 64 * kb, n0, F_Wgu_t, 256 * (n0 >> 7) + 128 + (n0 & 127), scr, F.lane); continue; } r -= I_G;
        { const int nb = r % (D / 32), kb = r / (D / 32); p0_transpose_item(F_w_down, D, FF, 64 * kb, 32 * nb, F_Wd_t, 32 * nb, scr, F.lane); }
    }
    __syncthreads();
    LAS f32x4* tbl = (LAS f32x4*)(F.lds + RING_OFF);
    for (int e = F.tid; e < 4096; e += NWAVES * 64) { const int l = e & 63, hq = (e >> 6) & 3, ci = e >> 8; const int col = 4 * l + 256 * (ci >> 2) + (ci & 3);
        const float* src = F_w_in + (size_t)col * INC + NIN + hq * 4; tbl[e] = (f32x4){src[0], src[1], src[2], src[3]}; }
    __syncthreads();
    f32x4 g[4];
#pragma unroll
    for (int j = 0; j < 4; ++j) g[j] = *(const f32x4*)(F_g_pre + 4 * F.lane + 256 * j);
    const float dtb = F_ssd_dtb[F.lane & 15];
    for (int r0 = gw * 4; r0 < M; r0 += NGW * 4) {
        f32x4 xv[4][4];
#pragma unroll
        for (int rr = 0; rr < 4; ++rr) {
            const float* xr = F_x + (size_t)(r0 + rr) * D + 4 * F.lane; float ss = 0.f;
#pragma unroll
            for (int j = 0; j < 4; ++j) { xv[rr][j] = *(const f32x4*)(xr + 256 * j); ss += (xv[rr][j].x * xv[rr][j].x + xv[rr][j].y * xv[rr][j].y) + (xv[rr][j].z * xv[rr][j].z + xv[rr][j].w * xv[rr][j].w); }
            const float rstd = 1.0f / sqrtf(wave_sum(ss) * (1.0f / D) + EPS);
            GAS unsigned long long* o8 = (GAS unsigned long long*)(F_XN + (size_t)(r0 + rr) * D) + F.lane;
#pragma unroll
            for (int j = 0; j < 4; ++j) { xv[rr][j] = xv[rr][j] * rstd * g[j];
                o8[64 * j] = (unsigned long long)pk2(xv[rr][j].x, xv[rr][j].y) | ((unsigned long long)pk2(xv[rr][j].z, xv[rr][j].w) << 32); }
        }
        float v[64];
#pragma unroll
        for (int i = 0; i < 64; ++i) v[i] = 0.f;
#pragma unroll
        for (int j = 0; j < 4; ++j)
#pragma unroll
            for (int e = 0; e < 4; ++e)
#pragma unroll
                for (int hq = 0; hq < 4; ++hq) { const f32x4 w = tbl[((j * 4 + e) * 4 + hq) * 64 + F.lane];
#pragma unroll
                    for (int rr = 0; rr < 4; ++rr) { const float xe = xv[rr][j][e];
                        v[rr * 16 + hq * 4 + 0] += xe * w.x; v[rr * 16 + hq * 4 + 1] += xe * w.y; v[rr * 16 + hq * 4 + 2] += xe * w.z; v[rr * 16 + hq * 4 + 3] += xe * w.w; }
                    if (hq == 3) asm volatile("" ::: "memory"); }
#pragma unroll
        for (int half = 32; half >= 1; half >>= 1) { const bool up = (F.lane & half) != 0;
#pragma unroll
            for (int i = 0; i < half; ++i) { const float send = up ? v[i] : v[i + half]; const float keep = up ? v[i + half] : v[i]; v[i] = keep + __shfl_xor(send, half); } }
        F_DTV[(size_t)(r0 + (F.lane >> 4)) * 16 + (F.lane & 15)] = softplusf_(v[0] + dtb);
    }
}

__device__ __forceinline__ void lru_baseline_unit(Frame& F, int unit) {
    const int b = unit >> 4, blk = unit & 15, lane = F.lane, ch = blk * 64 + lane;
    LAS float* wl = (LAS float*)(F.lds + RING_OFF);
#pragma unroll 8
    for (int i = 0; i < 64; ++i) { wl[i * 64 + lane] = F_lru_wa[blk * 4096 + i * 64 + lane]; wl[4096 + i * 64 + lane] = F_lru_wx[blk * 4096 + i * 64 + lane]; }
    LDS_WAIT(); asm volatile("" ::: "memory");
    const float ba = F_lru_ba[ch], bx = F_lru_bx[ch], sp = softplusf_(-F_lru_lam[ch]);
    const float c0 = F_lru_cw[ch], c1 = F_lru_cw[1024 + ch], c2 = F_lru_cw[2048 + ch], c3 = F_lru_cw[3072 + ch], cb = F_lru_cb[ch];
    float xm3 = 0.f, xm2 = 0.f, xm1 = 0.f, h = 0.f;
    const bf16* px = F_PROJ + (size_t)(b * T) * NIN + PC_LX + ch; const bf16* pg = F_PROJ + (size_t)(b * T) * NIN + PC_LG + ch;
    for (int t0 = 0; t0 < T; t0 += 8) {
        float xr[8], gr[8];
#pragma unroll
        for (int j = 0; j < 8; ++j) { xr[j] = bf2f(px[(size_t)(t0 + j) * NIN]); gr[j] = bf2f(pg[(size_t)(t0 + j) * NIN]); }
#pragma unroll
        for (int j = 0; j < 8; ++j) {
            const float x0 = xr[j]; const float lx = cb + c0 * xm3 + c1 * xm2 + c2 * xm1 + c3 * x0; xm3 = xm2; xm2 = xm1; xm1 = x0;
            float rp = ba, ip = bx;
#pragma unroll
            for (int i = 0; i < 64; ++i) { const float s = __builtin_bit_cast(float, __builtin_amdgcn_readlane(__builtin_bit_cast(int, lx), i)); rp = fmaf(s, wl[i * 64 + lane], rp); ip = fmaf(s, wl[4096 + i * 64 + lane], ip); }
            const float r = sigmoidf_(rp), ig = sigmoidf_(ip), la = -8.0f * r * sp, a = expf(la), mult = sqrtf(-expm1f(2.0f * la));
            h = a * h + mult * (ig * lx);
            const float y = h * gelu_tanhf_(gr[j]);
            const float ss = wave_sum(y * y);
            const size_t row = (size_t)(b * T + t0 + j);
            F_YMIX[row * MIXW + ch] = (bf16)f2bf(y);
            if (lane == 0) F_PART[row * 32 + blk] = ss;
        }
    }
}
__device__ __forceinline__ float ssd_convsilu(Frame& F, int b, int t, int c) {
    float acc = F_ssd_cb[c];
#pragma unroll
    for (int k = 0; k < 4; ++k) { const int tk = t - 3 + k; if (tk >= 0) acc += F_ssd_cw[k * XBC + c] * bf2f(F_PROJ[(size_t)(b * T + tk) * NIN + PC_X + c]); }
    return siluf_(acc);
}
__device__ __forceinline__ void ssd_baseline_unit(Frame& F, int unit) {
    const int b = unit >> 4, h = unit & 15, g = h >> 3, tid = F.tid, p = tid >> 3, nq = tid & 7;
    LAS float* Bs = (LAS float*)(F.lds + RING_OFF);
    LAS float* Cs = Bs + 32 * 128;
    LAS float* xs = Cs + 32 * 128;
    LAS float* zs = xs + 32 * 64;
    LAS float* yb = zs + 32 * 64;
    LAS float* dts = yb + 32 * 64;
    const float A = -expf(F_ssd_alog[h]), Dh = F_ssd_d[h];
    float S[16];
#pragma unroll
    for (int i = 0; i < 16; ++i) S[i] = 0.f;
    for (int t0 = 0; t0 < T; t0 += 32) {
        for (int e = tid; e < 32 * 128; e += NWAVES * 64) { const int tt = e >> 7, n = e & 127;
            Bs[e] = ssd_convsilu(F, b, t0 + tt, 1024 + g * 128 + n); Cs[e] = ssd_convsilu(F, b, t0 + tt, 1280 + g * 128 + n); }
        for (int e = tid; e < 32 * 64; e += NWAVES * 64) { const int tt = e >> 6, pp = e & 63;
            xs[e] = ssd_convsilu(F, b, t0 + tt, h * 64 + pp); zs[e] = bf2f(F_PROJ[(size_t)(b * T + t0 + tt) * NIN + PC_Z + h * 64 + pp]); }
        if (tid < 32) dts[tid] = F_DTV[(size_t)(b * T + t0 + tid) * 16 + h];
        __syncthreads();
        for (int tt = 0; tt < 32; ++tt) {
            const float dtv = dts[tt], da = expf(dtv * A), xv = xs[tt * 64 + p], dtx = dtv * xv; float yp = 0.f;
#pragma unroll
            for (int i = 0; i < 16; ++i) { const float Bv = Bs[tt * 128 + nq * 16 + i], Cv = Cs[tt * 128 + nq * 16 + i]; S[i] = S[i] * da + dtx * Bv; yp += Cv * S[i]; }
            yp += __shfl_xor(yp, 1); yp += __shfl_xor(yp, 2); yp += __shfl_xor(yp, 4);
            if (nq == 0) { const float z = zs[tt * 64 + p]; yb[tt * 64 + p] = (yp + Dh * xv) * siluf_(z); }
        }
        __syncthreads();
        for (int e = tid; e < 32 * 64; e += NWAVES * 64) { const int tt = e >> 6, pp = e & 63; F_YMIX[(size_t)(b * T + t0 + tt) * MIXW + 1024 + h * 64 + pp] = (bf16)f2bf(yb[e]); }
#pragma unroll
        for (int r = 0; r < 4; ++r) { const int tt = 4 * F.wave + r; const float v = yb[tt * 64 + F.lane]; const float ss = wave_sum(v * v);
            if (F.lane == 0) F_PART[(size_t)(b * T + t0 + tt) * 32 + 16 + h] = ss; }
        __syncthreads();
    }
}
__device__ __forceinline__ void p2_mixer_baseline(Frame& F) {
    const int j = (int)blockIdx.x;
    for (int u = j; u < 256; u += F.G) {
        if (u < 128) ssd_baseline_unit(F, u);
        else if (F.wave == 0) lru_baseline_unit(F, u - 128);
        __syncthreads();
    }
}
__device__ __forceinline__ void p3_ymix_norm(Frame& F) {
    const int gw = F.vcu * NWAVES + F.wave, NGW = F.G * NWAVES, lane = F.lane;
    float gn[4][8];
#pragma unroll
    for (int j = 0; j < 4; ++j)
#pragma unroll
        for (int e = 0; e < 8; ++e) { const int c = 8 * lane + 512 * j + e; gn[j][e] = (j < 2) ? F_g_lru[c] : F_g_ssd[c - 1024]; }
    for (int row = gw; row < M; row += NGW) {
        float s = F_PART[(size_t)row * 32 + (lane & 31)];
        s += __shfl_xor(s, 1); s += __shfl_xor(s, 2); s += __shfl_xor(s, 4); s += __shfl_xor(s, 8);
        const float sl = __shfl(s, 0), ssd = __shfl(s, 16);
        const float rl = 1.0f / sqrtf(sl * (1.0f / 1024.0f) + EPS), rs = 1.0f / sqrtf(ssd * (1.0f / 1024.0f) + EPS);
        GAS v4u* yp = (GAS v4u*)(F_YMIX + (size_t)row * MIXW) + lane;
#pragma unroll
        for (int j = 0; j < 4; ++j) { const v4u w = yp[64 * j]; const float sc = (j < 2) ? rl : rs; v4u o;
            o.x = pk2(bflo(w.x) * sc * gn[j][0], bfhi(w.x) * sc * gn[j][1]); o.y = pk2(bflo(w.y) * sc * gn[j][2], bfhi(w.y) * sc * gn[j][3]);
            o.z = pk2(bflo(w.z) * sc * gn[j][4], bfhi(w.z) * sc * gn[j][5]); o.w = pk2(bflo(w.w) * sc * gn[j][6], bfhi(w.w) * sc * gn[j][7]);
            yp[64 * j] = o; }
    }
}
__device__ __forceinline__ void p5_post_mix(Frame& F) {
    const int gw = F.vcu * NWAVES + F.wave, NGW = F.G * NWAVES, lane = F.lane;
    f32x4 gm[4], gf[4];
#pragma unroll
    for (int j = 0; j < 4; ++j) { gm[j] = *(const f32x4*)(F_g_pm + 4 * lane + 256 * j); gf[j] = *(const f32x4*)(F_g_pf + 4 * lane + 256 * j); }
    for (int row = gw; row < M; row += NGW) {
        const GAS unsigned long long* mp = (const GAS unsigned long long*)(F_MIXF + (size_t)row * D) + lane;
        const GAS f32x4* xp = (const GAS f32x4*)(F_x + (size_t)row * D) + lane;
        f32x4 mv[4], xv[4]; float ss = 0.f;
#pragma unroll
        for (int j = 0; j < 4; ++j) { const unsigned long long w = mp[64 * j]; const unsigned lo = (unsigned)w, hi = (unsigned)(w >> 32);
            mv[j] = (f32x4){bflo(lo), bfhi(lo), bflo(hi), bfhi(hi)}; xv[j] = xp[64 * j];
            ss += (mv[j].x * mv[j].x + mv[j].y * mv[j].y) + (mv[j].z * mv[j].z + mv[j].w * mv[j].w); }
        const float rm = 1.0f / sqrtf(wave_sum(ss) * (1.0f / D) + EPS);
        float s1 = 0.f;
        GAS f32x4* op = (GAS f32x4*)(F.out + (size_t)row * D) + lane;
#pragma unroll
        for (int j = 0; j < 4; ++j) { xv[j] = xv[j] + mv[j] * rm * gm[j]; op[64 * j] = xv[j];
            s1 += (xv[j].x * xv[j].x + xv[j].y * xv[j].y) + (xv[j].z * xv[j].z + xv[j].w * xv[j].w); }
        const float r1 = 1.0f / sqrtf(wave_sum(s1) * (1.0f / D) + EPS);
        GAS unsigned long long* hp = (GAS unsigned long long*)(F_XN + (size_t)row * D) + lane;
#pragma unroll
        for (int j = 0; j < 4; ++j) { const f32x4 hv = xv[j] * r1 * gf[j]; hp[64 * j] = (unsigned long long)pk2(hv.x, hv.y) | ((unsigned long long)pk2(hv.z, hv.w) << 32); }
    }
}
__device__ __forceinline__ void p8_post_ffn(Frame& F) {
    const int gw = F.vcu * NWAVES + F.wave, NGW = F.G * NWAVES, lane = F.lane;
    f32x4 gp[4];
#pragma unroll
    for (int j = 0; j < 4; ++j) gp[j] = *(const f32x4*)(F_g_post + 4 * lane + 256 * j);
    for (int row = gw; row < M; row += NGW) {
        const GAS unsigned long long* mp = (const GAS unsigned long long*)(F_MIXF + (size_t)row * D) + lane;
        GAS f32x4* op = (GAS f32x4*)(F.out + (size_t)row * D) + lane;
        f32x4 mv[4], xv[4]; float ss = 0.f;
#pragma unroll
        for (int j = 0; j < 4; ++j) { const unsigned long long w = mp[64 * j]; const unsigned lo = (unsigned)w, hi = (unsigned)(w >> 32);
            mv[j] = (f32x4){bflo(lo), bfhi(lo), bflo(hi), bfhi(hi)}; xv[j] = op[64 * j];
            ss += (mv[j].x * mv[j].x + mv[j].y * mv[j].y) + (mv[j].z * mv[j].z + mv[j].w * mv[j].w); }
        const float rm = 1.0f / sqrtf(wave_sum(ss) * (1.0f / D) + EPS);
#pragma unroll
        for (int j = 0; j < 4; ++j) op[64 * j] = xv[j] + mv[j] * rm * gp[j];
    }
}

struct Args { const float* in[24]; float* out; unsigned char* ws; int ph_lo, ph_hi, li, pad; };
__global__ void __launch_bounds__(NWAVES * 64, 2) hyb_fwd(Args args) {
    extern __shared__ __attribute__((aligned(16))) unsigned char lds[];
    Frame F;
    F.lds = (LAS unsigned char*)lds;
    F.MISC = (volatile LAS unsigned*)(F.lds + MISC_OFF);
    F.tid = threadIdx.x; F.lane = F.tid & 63; F.wave = __builtin_amdgcn_readfirstlane(F.tid >> 6);
    F.G = gridDim.x; { const int bx = blockIdx.x; F.vcu = (F.G % 8 == 0) ? (bx % 8) * (F.G / 8) + bx / 8 : bx; }
    unsigned char* ws = args.ws;
    F.ctl = (gu32*)(ws + WS_CTL);
    F.in = args.in; F.out = args.out; F.ws = ws;
    for (int u = F.tid; u < (LDS_BYTES - LDSCTL_OFF) / 4; u += NWAVES * 64) ((LAS unsigned*)(F.lds + LDSCTL_OFF))[u] = 0u;
    __syncthreads();
    XcdBarrier bar; bar.bar = (unsigned*)(F.ctl + CW_BAR); bar.x = 0; bar.st = nullptr;
    if (N_LAUNCHES == 1) bar = xcd_barrier_post((unsigned*)(F.ctl + CW_BAR), F.MISC + 8);
#define GRID_BAR() do { if (N_LAUNCHES == 1) xcd_barrier(bar); } while (0)
    const int lo = args.ph_lo, hi = args.ph_hi;
#ifndef PHMASK
#define PHMASK 0x1ff
#endif
#define IN(k) (((PHMASK >> (k)) & 1) && lo <= (k) && (k) < hi)
#define BOTH(k) (IN(k) && IN((k) + 1))

    if (IN(0)) { p0_prologue(F); if (BOTH(0)) GRID_BAR(); }
    if (IN(1)) {
        pg8::Gemm g{F_XN, F_Win_t, M, NIN, D}; pg8::StaticOrder S; S.init(M, NIN, F.G, (int)blockIdx.x);
        pg8::EpiBf16<0> E{F_PROJ, NIN, nullptr, 0, 0, 1.f};
        pg8::gemm_phase<pg8::EpiBf16<0>, pg8::StaticOrder, PG8_ALIGN, PG8_SP2>(F.lds + RING_OFF, g, S, E);
        if (BOTH(1)) GRID_BAR();
    }
    if (IN(2)) { p2_mixer_baseline(F); if (BOTH(2)) GRID_BAR(); }
    if (IN(3)) { p3_ymix_norm(F); if (BOTH(3)) GRID_BAR(); }
    if (IN(4)) {
        pg8::Gemm g{F_YMIX, F_Wout_t, M, D, MIXW}; pg8::StaticOrder S; S.init(M, D, F.G, (int)blockIdx.x);
        pg8::EpiBf16<0> E{F_MIXF, D, nullptr, 0, 0, 1.f};
        pg8::gemm_phase<pg8::EpiBf16<0>, pg8::StaticOrder, PG8_ALIGN, PG8_SP2>(F.lds + RING_OFF, g, S, E);
        if (BOTH(4)) GRID_BAR();
    }
    if (IN(5)) { p5_post_mix(F); if (BOTH(5)) GRID_BAR(); }
    if (IN(6)) {
        pg8::Gemm g{F_XN, F_Wgu_t, M, NGU, D}; pg8::StaticOrder S; S.init(M, NGU, F.G, (int)blockIdx.x);
        pg8::EpiSwiGLU E{F_HID, FF};
        pg8::gemm_phase<pg8::EpiSwiGLU, pg8::StaticOrder, PG8_ALIGN, PG8_SP2>(F.lds + RING_OFF, g, S, E);
        if (BOTH(6)) GRID_BAR();
    }
    if (IN(7)) {
        pg8::Gemm g{F_HID, F_Wd_t, M, D, FF}; pg8::StaticOrder S; S.init(M, D, F.G, (int)blockIdx.x);
        pg8::EpiBf16<0> E{F_MIXF, D, nullptr, 0, 0, 1.f};
        pg8::gemm_phase<pg8::EpiBf16<0>, pg8::StaticOrder, PG8_ALIGN, PG8_SP2>(F.lds + RING_OFF, g, S, E);
        if (BOTH(7)) GRID_BAR();
    }
    if (IN(8)) { p8_post_ffn(F); }
#undef IN
#undef BOTH
}

extern "C" void kernel_launch(void* const* d_in, const int* in_sizes, int n_in, void* d_out, int out_size, void* d_ws, size_t ws_size, hipStream_t stream) {
    static int grid = 0;
    if (grid == 0) {
        if (n_in != 24 || in_sizes[0] != M * D || out_size != M * D || ws_size < WS_END) { fprintf(stderr, "kernel_launch: unexpected shapes: n_in %d in0 %d out %d ws %zu\n", n_in, n_in > 0 ? in_sizes[0] : -1, out_size, ws_size); grid = -1; return; }
        int dev = 0, cus = 0, per_cu = 0;
        if (hipGetDevice(&dev) != hipSuccess || hipDeviceGetAttribute(&cus, hipDeviceAttributeMultiprocessorCount, dev) != hipSuccess) { grid = -1; return; }
        if (hipFuncSetAttribute((const void*)hyb_fwd, hipFuncAttributeMaxDynamicSharedMemorySize, LDS_BYTES) != hipSuccess) { fprintf(stderr, "kernel_launch: hipFuncSetAttribute failed\n"); grid = -1; return; }
        if (hipOccupancyMaxActiveBlocksPerMultiprocessor(&per_cu, (const void*)hyb_fwd, NWAVES * 64, LDS_BYTES) != hipSuccess || per_cu < 1) { fprintf(stderr, "kernel_launch: occupancy query says %d blocks per CU\n", per_cu); (void)hipGetLastError(); grid = -1; return; }
        grid = cus;
    }
    if (grid < 0) return;
    (void)hipMemsetAsync((char*)d_ws + WS_CTL, 0, CTL_ZERO_BYTES, stream);
    Args a{};
    for (int i = 0; i < 24; ++i) a.in[i] = (const float*)d_in[i];
    a.out = (float*)d_out; a.ws = (unsigned char*)d_ws;
    for (int li = 0; li < N_LAUNCHES; ++li) {
        a.ph_lo = (N_LAUNCHES == NPH) ? li : 0; a.ph_hi = (N_LAUNCHES == NPH) ? li + 1 : NPH; a.li = li;
        hipLaunchKernelGGL(hyb_fwd, dim3(grid), dim3(NWAVES * 64), LDS_BYTES, stream, a);
    }
}
```

```cpp
#include <hip/hip_runtime.h>
#include <cstdio>
#include <cstdint>
namespace pg8 {
#define PG8_LAS __attribute__((address_space(3)))
typedef unsigned short bf16_t;
typedef short bf16x8 __attribute__((ext_vector_type(8)));
typedef float f32x4 __attribute__((ext_vector_type(4)));
typedef unsigned u32x4 __attribute__((ext_vector_type(4)));
constexpr int BM = 256, BK = 64, HALF = 128, HTB = HALF * BK * 2  , STAGE_BYTES = 8 * HTB, NXCD = 8, WGM = 8;

__host__ __device__ __forceinline__ int lds_byte(int r, int c) { const int st = (r >> 4) * 2 + (c >> 5), rr = r & 15, cc = c & 31, ob = rr * 64 + cc * 2; return st * 1024 + (ob ^ (((ob >> 9) & 1) << 5)); }
__host__ __device__ __forceinline__ void stage_rc(int b, int& R, int& C) { const int st = b / 1024, sb = b % 1024, swz = sb ^ (((sb >> 9) & 1) << 5); R = (st >> 1) * 16 + swz / 64; C = (st & 1) * 32 + (swz % 64) / 2; }
__host__ __device__ __forceinline__ int perm32(int rho) { const int n = rho >> 4, i = rho & 15; return 8 * (i >> 2) + 4 * n + (i & 3); }

struct Unit { int pm, pn; };
struct Gemm { const bf16_t* A; const bf16_t* Bt; int M, N, K; };

struct StaticOrder {
    int nM, nN, nwg, G, c;
    __host__ __device__ void init(int M, int N, int G_, int c_) { nM = M / BM; nN = N / BM; nwg = nM * nN; G = G_; c = c_; }
    __host__ __device__ bool next(int i, Unit& u) const {
        const long L = (long)i * G + c; if (L >= nwg) return false;
        int wgid = (int)L; { const int q = nwg / NXCD, r = nwg % NXCD, xcd = wgid % NXCD, off = wgid / NXCD; wgid = (xcd < r ? xcd * (q + 1) : r * (q + 1) + (xcd - r) * q) + off; }
        const int nig = WGM * nN, gid = wgid / nig, fm = gid * WGM, gsz = (nM - fm) < WGM ? (nM - fm) : WGM;
        u.pm = fm + ((wgid % nig) % gsz); u.pn = (wgid % nig) / gsz; return true;
    }
    __device__ __forceinline__ void a_ready(const Unit&) const {}
    __device__ __forceinline__ void done(const Unit&) const {}
};

__device__ __forceinline__ unsigned cvt_pk_bf16(float lo, float hi) { unsigned r; asm volatile("v_cvt_pk_bf16_f32 %0, %1, %2" : "=v"(r) : "v"(lo), "v"(hi)); return r; }
typedef float f32x2 __attribute__((ext_vector_type(2)));
__device__ __forceinline__ f32x2 gelu_pk(f32x2 v) {
    const f32x2 av = __builtin_elementwise_abs(v), d = av * 0.2316418882f + 1.0f;
    f32x2 t; t.x = __builtin_amdgcn_rcpf(d.x); t.y = __builtin_amdgcn_rcpf(d.y);
    f32x2 q = t * 0.5307027145f + (-0.7265760135f); q = q * t + 0.7107068705f; q = q * t + (-0.142248368f); q = q * t + 0.127414796f; q = q * t;
    const f32x2 s = (v * v) * (-0.72134752044f);
    f32x2 e; e.x = __builtin_amdgcn_exp2f(s.x); e.y = __builtin_amdgcn_exp2f(s.y);
    const f32x2 m = v * (q * e), r = v - m;
    f32x2 o; o.x = v.x < 0.f ? m.x : r.x; o.y = v.y < 0.f ? m.y : r.y; return o;
}

template <int ACT  > struct EpiBf16 {
    static constexpr bool PERM = true, AFTER_DRAIN = false; static_assert(ACT == 0 || ACT == 1, "EpiBf16: ACT is 0 (none) or 1 (gelu_pk)");
    bf16_t* O; int ldc; const float* bias; int split_cols; size_t split_stride; float scale0;
    __device__ __forceinline__ void operator()(const f32x4 (&acc)[2][2][4][2], const Unit& u, int wr, int wc, int fr, int fq) const {
        const int row0 = u.pm * BM + wr * 64 + fr; int colt = u.pn * BM; bf16_t* base = O;
        float sc = 1.f; if (split_cols) { const int t = colt / split_cols; base += (size_t)t * split_stride; colt -= t * split_cols; if (t == 0) sc = scale0; }
        const int col0 = colt + wc * 32 + 8 * fq, bcol0 = u.pn * BM + wc * 32 + 8 * fq;
        f32x4 bv[2][2];
#pragma unroll
        for (int bj = 0; bj < 2; ++bj)
#pragma unroll
            for (int n = 0; n < 2; ++n) bv[bj][n] = bias ? *(const f32x4*)(bias + bcol0 + bj * HALF + 4 * n) : (f32x4){0.f, 0.f, 0.f, 0.f};
#pragma unroll
        for (int ai = 0; ai < 2; ++ai)
#pragma unroll
            for (int m = 0; m < 4; ++m) { bf16_t* rowp = base + (size_t)(row0 + ai * HALF + m * 16) * ldc + col0;
#pragma unroll
                for (int bj = 0; bj < 2; ++bj) { f32x4 v0 = acc[ai][bj][m][0] + bv[bj][0], v1 = acc[ai][bj][m][1] + bv[bj][1];
                    if (ACT == 1) { f32x2 a = gelu_pk((f32x2){v0[0], v0[1]}), b = gelu_pk((f32x2){v0[2], v0[3]}), c = gelu_pk((f32x2){v1[0], v1[1]}), d = gelu_pk((f32x2){v1[2], v1[3]});
                        v0 = (f32x4){a.x, a.y, b.x, b.y}; v1 = (f32x4){c.x, c.y, d.x, d.y}; }
                    v0 = v0 * sc; v1 = v1 * sc; u32x4 w; w.x = cvt_pk_bf16(v0[0], v0[1]); w.y = cvt_pk_bf16(v0[2], v0[3]); w.z = cvt_pk_bf16(v1[0], v1[1]); w.w = cvt_pk_bf16(v1[2], v1[3]);
                    *(u32x4*)(rowp + bj * HALF) = w; } }
    }
};
struct EpiSwiGLU {
    static constexpr bool PERM = true, AFTER_DRAIN = false;
    bf16_t* O; int ldc;
    __device__ __forceinline__ static float silu_mul(float g, float u) { return g * __builtin_amdgcn_rcpf(1.0f + __expf(-g)) * u; }
    __device__ __forceinline__ void operator()(const f32x4 (&acc)[2][2][4][2], const Unit& u, int wr, int wc, int fr, int fq) const {
        const int row0 = u.pm * BM + wr * 64 + fr; const int col0 = u.pn * HALF + wc * 32 + 8 * fq;
#pragma unroll
        for (int ai = 0; ai < 2; ++ai)
#pragma unroll
            for (int m = 0; m < 4; ++m) { bf16_t* rowp = O + (size_t)(row0 + ai * HALF + m * 16) * ldc + col0;
                const f32x4 g0 = acc[ai][0][m][0], g1 = acc[ai][0][m][1], u0 = acc[ai][1][m][0], u1 = acc[ai][1][m][1];
                u32x4 w; w.x = cvt_pk_bf16(silu_mul(g0[0], u0[0]), silu_mul(g0[1], u0[1])); w.y = cvt_pk_bf16(silu_mul(g0[2], u0[2]), silu_mul(g0[3], u0[3]));
                w.z = cvt_pk_bf16(silu_mul(g1[0], u1[0]), silu_mul(g1[1], u1[1])); w.w = cvt_pk_bf16(silu_mul(g1[2], u1[2]), silu_mul(g1[3], u1[3]));
                *(u32x4*)rowp = w; }
    }
};

template <class Epi, class Sched, bool ALIGN_EPI = false, bool SP2 = false>
__device__ __forceinline__ void gemm_phase(PG8_LAS unsigned char* lds, const Gemm g, const Sched& S, const Epi& E) {
    const int tid = threadIdx.x, wid = __builtin_amdgcn_readfirstlane(tid >> 6), lane = tid & 63, wr = wid >> 2, wc = wid & 3, fr = lane & 15, fq = lane >> 4;
    const int K = g.K, nt = K / BK;
    unsigned voffA[2], voffB[2];
#pragma unroll
    for (int i = 0; i < 2; ++i) { int R, C; stage_rc(tid * 16 + i * 8192, R, C); const int Rb = Epi::PERM ? ((R & ~31) + perm32(R & 31)) : R;
        voffA[i] = (unsigned)(R * K + C) * 2u; voffB[i] = (unsigned)(Rb * K + C) * 2u; }
    const size_t kstep = (size_t)(BK * 2);
    const size_t hstep = (size_t)HALF * K * 2;
    const size_t tstep = 2 * hstep;
    const unsigned ldsw = (unsigned)wid * 1024u;
    const int aoff = lds_byte(wr * 64 + fr, fq * 8), boff = lds_byte(wc * 32 + fr, fq * 8);
#define PG8_SA(b, h) (((b) * 2 + (h)) * HTB)
#define PG8_SB(b, h) ((4 + (b) * 2 + (h)) * HTB)
#define PG8_STAGE(bufoff, gbase, voff) do { _Pragma("unroll") for (int _i = 0; _i < 2; ++_i) \
        __builtin_amdgcn_global_load_lds((const unsigned*)((const char*)(gbase) + (voff)[_i]), (PG8_LAS unsigned*)(lds + (bufoff) + ldsw + _i * 8192), 16, 0, 0); } while (0)
#define PG8_LDA(dst, b, h) do { _Pragma("unroll") for (int m = 0; m < 4; ++m) _Pragma("unroll") for (int k = 0; k < 2; ++k) dst[m][k] = *(const PG8_LAS bf16x8*)(lds + PG8_SA(b, h) + aoff + m * 2048 + k * 1024); } while (0)
#define PG8_LDB(dst, b, h) do { _Pragma("unroll") for (int n = 0; n < 2; ++n) _Pragma("unroll") for (int k = 0; k < 2; ++k) dst[n][k] = *(const PG8_LAS bf16x8*)(lds + PG8_SB(b, h) + boff + n * 2048 + k * 1024); } while (0)
#define PG8_MMA(ai, bj, At, Bt) do { __builtin_amdgcn_s_setprio(1); _Pragma("unroll") for (int m = 0; m < 4; ++m) _Pragma("unroll") for (int n = 0; n < 2; ++n) _Pragma("unroll") for (int k = 0; k < 2; ++k) \
        acc[ai][bj][m][n] = __builtin_amdgcn_mfma_f32_16x16x32_bf16(Bt[n][k], At[m][k], acc[ai][bj][m][n], 0, 0, 0); __builtin_amdgcn_s_setprio(0); } while (0)
#define PG8_WAIT_V(n) asm volatile("s_waitcnt vmcnt(" #n ")" ::: "memory")
#define PG8_WAIT_L(n) asm volatile("s_waitcnt lgkmcnt(" #n ")" ::: "memory")
#define PG8_BAR __builtin_amdgcn_s_barrier()
#define PG8_SCHED __builtin_amdgcn_sched_barrier(0)
    Unit cur, nxt; int ui = 0;
    if (!S.next(0, cur)) return;
    f32x4 acc[2][2][4][2];
#pragma unroll
    for (int a = 0; a < 2; ++a)
#pragma unroll
        for (int b = 0; b < 2; ++b)
#pragma unroll
            for (int m = 0; m < 4; ++m)
#pragma unroll
                for (int n = 0; n < 2; ++n) acc[a][b][m][n] = (f32x4){0.f, 0.f, 0.f, 0.f};
    bf16x8 At[4][2], B0[2][2], B1[2][2];
    const char* cA = (const char*)g.A + (size_t)cur.pm * tstep; const char* cB = (const char*)g.Bt + (size_t)cur.pn * tstep;
    S.a_ready(cur);
    if constexpr (SP2) {
        PG8_STAGE(PG8_SB(0, 0), cB, voffB); PG8_STAGE(PG8_SB(0, 1), cB + hstep, voffB); PG8_STAGE(PG8_SA(0, 0), cA, voffA); PG8_STAGE(PG8_SA(0, 1), cA + hstep, voffA);
        if (wr == 1) PG8_BAR;
        PG8_WAIT_V(2); PG8_BAR;
        PG8_STAGE(PG8_SB(1, 0), cB + kstep, voffB); PG8_STAGE(PG8_SA(1, 0), cA + kstep, voffA); PG8_STAGE(PG8_SB(1, 1), cB + hstep + kstep, voffB);
        PG8_WAIT_V(6); PG8_BAR;
    } else {
        PG8_STAGE(PG8_SB(0, 0), cB, voffB); PG8_STAGE(PG8_SA(0, 0), cA, voffA); PG8_STAGE(PG8_SB(0, 1), cB + hstep, voffB); PG8_STAGE(PG8_SA(0, 1), cA + hstep, voffA);
        if (wr == 1) PG8_BAR;
        PG8_WAIT_V(4); PG8_BAR;
        PG8_STAGE(PG8_SB(1, 0), cB + kstep, voffB); PG8_STAGE(PG8_SA(1, 0), cA + kstep, voffA); PG8_STAGE(PG8_SB(1, 1), cB + hstep + kstep, voffB);
        PG8_WAIT_V(6); PG8_BAR;
    }
    for (;;) {
        const bool has_next = S.next(ui + 1, nxt);
        const char* nA = has_next ? (const char*)g.A + (size_t)nxt.pm * tstep : cA; const char* nB = has_next ? (const char*)g.Bt + (size_t)nxt.pn * tstep : cB;
        for (int t = 0; t < nt; t += 2) {
            const bool last = (t == nt - 2);
            const char* a1 = cA + (size_t)(t + 1) * kstep;
            const char* a2 = last ? nA : cA + (size_t)(t + 2) * kstep; const char* b2 = last ? nB : cB + (size_t)(t + 2) * kstep;
            const char* a3 = a2 + kstep; const char* b3 = b2 + kstep;
            if (last && has_next) S.a_ready(nxt);
            if constexpr (SP2) {
            PG8_LDB(B0, 0, 0); PG8_LDB(B1, 0, 1); PG8_SCHED; PG8_LDA(At, 0, 0); PG8_STAGE(PG8_SA(1, 1), a1 + hstep, voffA);
            PG8_WAIT_V(8); PG8_WAIT_L(0); PG8_BAR; PG8_MMA(0, 0, At, B0); PG8_MMA(0, 1, At, B1); PG8_BAR; PG8_SCHED;
            PG8_LDA(At, 0, 1); PG8_STAGE(PG8_SB(0, 0), b2, voffB); PG8_STAGE(PG8_SB(0, 1), b2 + hstep, voffB); PG8_STAGE(PG8_SA(0, 0), a2, voffA);
            PG8_WAIT_V(8); PG8_WAIT_L(0); PG8_BAR; PG8_MMA(1, 0, At, B0); PG8_MMA(1, 1, At, B1); PG8_BAR; PG8_SCHED;
            PG8_LDB(B0, 1, 0); PG8_LDB(B1, 1, 1); PG8_SCHED; PG8_LDA(At, 1, 0); PG8_STAGE(PG8_SA(0, 1), a2 + hstep, voffA);
            PG8_WAIT_V(8); PG8_WAIT_L(0); PG8_BAR; PG8_MMA(0, 0, At, B0); PG8_MMA(0, 1, At, B1); PG8_BAR; PG8_SCHED;
            PG8_LDA(At, 1, 1); PG8_STAGE(PG8_SB(1, 0), b3, voffB); PG8_STAGE(PG8_SB(1, 1), b3 + hstep, voffB); PG8_STAGE(PG8_SA(1, 0), a3, voffA);
            PG8_WAIT_V(8); PG8_WAIT_L(0); PG8_BAR; PG8_MMA(1, 0, At, B0); PG8_MMA(1, 1, At, B1); PG8_BAR; PG8_SCHED;
            } else {
            PG8_LDB(B0, 0, 0); PG8_SCHED; PG8_LDA(At, 0, 0); PG8_STAGE(PG8_SA(1, 1), a1 + hstep, voffA);
            PG8_WAIT_L(8); PG8_BAR; PG8_WAIT_L(0); PG8_MMA(0, 0, At, B0); PG8_BAR; PG8_SCHED;
            PG8_LDB(B1, 0, 1); PG8_STAGE(PG8_SB(0, 0), b2, voffB);
            PG8_BAR; PG8_WAIT_L(0); PG8_MMA(0, 1, At, B1); PG8_BAR;
            PG8_LDA(At, 0, 1); PG8_STAGE(PG8_SA(0, 0), a2, voffA);
            PG8_BAR; PG8_WAIT_L(0); PG8_MMA(1, 0, At, B0); PG8_BAR; PG8_SCHED;
            PG8_STAGE(PG8_SB(0, 1), b2 + hstep, voffB);
            PG8_WAIT_V(6); PG8_BAR; PG8_MMA(1, 1, At, B1); PG8_BAR;
            PG8_LDB(B0, 1, 0); PG8_SCHED; PG8_LDA(At, 1, 0); PG8_STAGE(PG8_SA(0, 1), a2 + hstep, voffA);
            PG8_WAIT_L(8); PG8_BAR; PG8_WAIT_L(0); PG8_MMA(0, 0, At, B0); PG8_BAR; PG8_SCHED;
            PG8_LDB(B1, 1, 1); PG8_STAGE(PG8_SB(1, 0), b3, voffB);
            PG8_BAR; PG8_WAIT_L(0); PG8_MMA(0, 1, At, B1); PG8_BAR;
            PG8_LDA(At, 1, 1); PG8_STAGE(PG8_SA(1, 0), a3, voffA);
            PG8_BAR; PG8_WAIT_L(0); PG8_MMA(1, 0, At, B0); PG8_BAR; PG8_SCHED;
            PG8_STAGE(PG8_SB(1, 1), b3 + hstep, voffB);
            PG8_WAIT_V(6); PG8_BAR; PG8_MMA(1, 1, At, B1); PG8_BAR;
            }
        }
        if constexpr (ALIGN_EPI) { if (wr == 0) PG8_BAR; }
        if constexpr (!Epi::AFTER_DRAIN) { E(acc, cur, wr, wc, fr, fq); S.done(cur); }
        if (!has_next) break;
#pragma unroll
        for (int a = 0; a < 2; ++a)
#pragma unroll
            for (int b = 0; b < 2; ++b)
#pragma unroll
                for (int m = 0; m < 4; ++m)
#pragma unroll
                    for (int n = 0; n < 2; ++n) acc[a][b][m][n] = (f32x4){0.f, 0.f, 0.f, 0.f};
        cur = nxt; cA = nA; cB = nB; ++ui;
        if constexpr (ALIGN_EPI) { if (wr == 1) PG8_BAR; }
    }
    PG8_WAIT_V(0);
    if constexpr (!ALIGN_EPI) { if (wr == 0) PG8_BAR; }
    PG8_BAR;
    if constexpr (Epi::AFTER_DRAIN) { E.fused(acc, cur, wr, wc, fr, fq, lds, wid, lane); S.done(cur); }
#undef PG8_SA
#undef PG8_SB
#undef PG8_STAGE
#undef PG8_LDA
#undef PG8_LDB
#undef PG8_MMA
#undef PG8_WAIT_V
#undef PG8_WAIT_L
#undef PG8_BAR
#undef PG8_SCHED
}
}

#ifndef PG8_SP2
#define PG8_SP2 true
#endif
#ifndef PG8_ALIGN
#define PG8_ALIGN true
#endif
constexpr int NWAVES = 8;
constexpr int NPH = 9;
#ifndef MK_N_LAUNCHES
#define MK_N_LAUNCHES 1
#endif
constexpr int N_LAUNCHES = MK_N_LAUNCHES;
static_assert(N_LAUNCHES == 1 || N_LAUNCHES == NPH, "MK_N_LAUNCHES is 1 (one launch) or 9 (test build: one launch per phase)");

constexpr int BATCH = 8, T = 8192, D = 1024, M = BATCH * T;
constexpr int INC = 4624, NIN = 4608;
constexpr int FF = 2816, NGU = 2 * FF, MIXW = 2048, XBC = 1536;
constexpr int PC_LX = 0, PC_LG = 1024, PC_Z = 2048, PC_X = 3072, PC_B = 4096, PC_C = 4352;
constexpr float EPS = 1e-6f;

constexpr size_t MiB = 1u << 20;
constexpr size_t WS_CTL = 0, CTL_ZERO_BYTES = 1 * MiB;
constexpr size_t WS_WIN = 2 * MiB, WS_WOUT = 11 * MiB, WS_WGU = 15 * MiB, WS_WD = 26 * MiB;
constexpr size_t WS_DTV = 32 * MiB;
constexpr size_t WS_PART = 36 * MiB;
constexpr size_t WS_PROJ = 64 * MiB;
constexpr size_t WS_XN = 640 * MiB;
constexpr size_t WS_YMIX = 768 * MiB;
constexpr size_t WS_HID = 64 * MiB;
constexpr size_t WS_MIXF = 416 * MiB;
constexpr size_t WS_END = 1024 * MiB;
static_assert(WS_WIN + (size_t)NIN * D * 2 <= WS_WOUT && WS_WOUT + (size_t)D * MIXW * 2 <= WS_WGU && WS_WGU + (size_t)NGU * D * 2 <= WS_WD && WS_WD + (size_t)D * FF * 2 <= WS_DTV, "weights map");
static_assert(WS_DTV + (size_t)M * 16 * 4 <= WS_PART && WS_PART + (size_t)M * 32 * 4 <= WS_PROJ && WS_PROJ + (size_t)M * NIN * 2 <= WS_XN && WS_XN + (size_t)M * D * 2 <= WS_YMIX && WS_YMIX + (size_t)M * MIXW * 2 <= WS_END, "d_ws map");
static_assert(WS_HID + (size_t)M * FF * 2 <= WS_MIXF && WS_MIXF + (size_t)M * D * 2 <= WS_XN, "overlay map");
constexpr int CW_TMO = 0, CW_CODE = 1;
constexpr int CW_BAR = 4096;

constexpr int RING_OFF = 0, RING_BYTES = 131072;
constexpr int LDS_BYTES = 163840;
constexpr int LDSCTL_OFF = LDS_BYTES - 512, MISC_OFF = LDSCTL_OFF + 320;
static_assert(MISC_OFF + 128 <= LDS_BYTES, "LDS map");
#define GAS __attribute__((address_space(1)))
#define LAS __attribute__((address_space(3)))
typedef unsigned short bf16;
typedef unsigned v4u __attribute__((ext_vector_type(4)));
typedef float f32x4 __attribute__((ext_vector_type(4)));
typedef short bf16x8 __attribute__((ext_vector_type(8)));
typedef GAS unsigned gu32;
typedef GAS unsigned long long gu64;
#define RLX_AGENT __ATOMIC_RELAXED, __HIP_MEMORY_SCOPE_AGENT
#define LDS_WAIT() asm volatile("s_waitcnt lgkmcnt(0)" ::: "memory")
#define VM_WAIT() asm volatile("s_waitcnt vmcnt(0)" ::: "memory")
__device__ __forceinline__ unsigned long long rt() { return __builtin_amdgcn_s_memrealtime(); }
__device__ __forceinline__ unsigned f2bf(float f) { unsigned u = __builtin_bit_cast(unsigned, f); return (u + 0x7fffu + ((u >> 16) & 1u)) >> 16; }
__device__ __forceinline__ unsigned pk2(float lo, float hi) { return f2bf(lo) | (f2bf(hi) << 16); }

#define XB_TMO      128
#define XB_XCNT(j)  (256  + 64 * (j))
#define XB_XSUB(j)  (1280 + 64 * (j))
#define XB_XGEN(j)  (2304 + 64 * (j))
#define XB_TOP      3328
#define XB_TOPGEN   3392
#define XCD_BAR_WORDS 3456
#define XB_SPIN_CAP (1u << 18)

__device__ __forceinline__ unsigned xb_ld(unsigned* p)              { return __hip_atomic_load(p, __ATOMIC_RELAXED, __HIP_MEMORY_SCOPE_AGENT); }
__device__ __forceinline__ unsigned xb_add(unsigned* p, unsigned v) { return __hip_atomic_fetch_add(p, v, __ATOMIC_RELAXED, __HIP_MEMORY_SCOPE_AGENT); }
__device__ __forceinline__ unsigned xb_xcc_id() { return (unsigned)__builtin_amdgcn_s_getreg((3 << 11) | 20) & 0xFu; }
#define XB_SPIN(cond, bar) do { unsigned _sp = 0; while (cond) { __builtin_amdgcn_s_sleep(1); \
    if ((++_sp & 255u) == 0u) { if (xb_ld(&(bar)[XB_TMO])) break; if (_sp > XB_SPIN_CAP) { atomicAdd(&(bar)[XB_TMO], 1u); break; } } } } while (0)

struct XcdBarrier {
    unsigned* bar; unsigned x;
    volatile LAS unsigned* st;
};

__device__ __forceinline__ XcdBarrier xcd_barrier_post(unsigned* bar, volatile LAS unsigned* st) {
    XcdBarrier b; b.bar = bar; b.x = xb_xcc_id(); b.st = st;
    if (threadIdx.x == 0) (void)xb_add(&bar[XB_XCNT(b.x)], 1u);
    return b;
}
__device__ __forceinline__ void xcd_barrier_complete(unsigned* bar, unsigned x, unsigned& nloc, unsigned& nx) {
    const unsigned G = gridDim.x * gridDim.y * gridDim.z;
    unsigned sum, cnt, mine, sp = 0u;
    for (;;) {
        sum = 0u; cnt = 0u; mine = 0u;
#pragma unroll
        for (unsigned j = 0; j < 16; ++j) { const unsigned c = xb_ld(&bar[XB_XCNT(j)]); sum += c; cnt += (c > 0u) ? 1u : 0u; mine = (j == x) ? c : mine; }
        if (sum == G) break;
        __builtin_amdgcn_s_sleep(1);
        if ((++sp & 255u) == 0u) { if (xb_ld(&bar[XB_TMO])) break; if (sp > XB_SPIN_CAP) { atomicAdd(&bar[XB_TMO], 1u); break; } }
    }
    nloc = mine > 0u ? mine : 1u; nx = cnt > 0u ? cnt : 1u;
}

__device__ __forceinline__ void xcd_barrier(const XcdBarrier& b) {
    asm volatile("s_waitcnt vmcnt(0)" ::: "memory");
    __syncthreads();
    if (threadIdx.x == 0) {
        unsigned* bar = b.bar;
        __builtin_amdgcn_s_waitcnt(0);
        unsigned nloc = b.st[0], nx = b.st[1];
        if (nloc == 0u) { xcd_barrier_complete(bar, b.x, nloc, nx); b.st[0] = nloc; b.st[1] = nx; }
        const unsigned old = xb_add(&bar[XB_XSUB(b.x)], 1u);
        const unsigned gen = old / nloc;
        if (old + 1u == (gen + 1u) * nloc) {
            __builtin_amdgcn_fence(__ATOMIC_RELEASE, "agent");
            asm volatile("s_waitcnt vmcnt(0)" ::: "memory");
            const unsigned og = xb_add(&bar[XB_TOP], 1u);
            const unsigned tg = og / nx;
            if (og + 1u == (tg + 1u) * nx) xb_add(&bar[XB_TOPGEN], 1u);
            else XB_SPIN(xb_ld(&bar[XB_TOPGEN]) == tg, bar);
            __builtin_amdgcn_fence(__ATOMIC_ACQUIRE, "agent");
            xb_add(&bar[XB_XGEN(b.x)], 1u);
            asm volatile("s_waitcnt vmcnt(0)" ::: "memory");
        } else {
            XB_SPIN(xb_ld(&bar[XB_XGEN(b.x)]) == gen, bar);
            __builtin_amdgcn_fence(__ATOMIC_ACQUIRE, "agent");
            asm volatile("s_waitcnt vmcnt(0)" ::: "memory");
        }
    }
    __syncthreads();
}

struct Frame {
    LAS unsigned char* lds;
    volatile LAS unsigned* MISC;
    gu32* ctl;
    int tid, lane, wave;
    int vcu, G;
    const float* const* in; float* out; unsigned char* ws;
};
#define F_x        (F.in[0])
#define F_g_pre    (F.in[1])
#define F_w_in     (F.in[2])
#define F_lru_cw   (F.in[3])
#define F_lru_cb   (F.in[4])
#define F_lru_wa   (F.in[5])
#define F_lru_ba   (F.in[6])
#define F_lru_wx   (F.in[7])
#define F_lru_bx   (F.in[8])
#define F_lru_lam  (F.in[9])
#define F_g_lru    (F.in[10])
#define F_ssd_cw   (F.in[11])
#define F_ssd_cb   (F.in[12])
#define F_ssd_dtb  (F.in[13])
#define F_ssd_alog (F.in[14])
#define F_ssd_d    (F.in[15])
#define F_g_ssd    (F.in[16])
#define F_w_out    (F.in[17])
#define F_g_pm     (F.in[18])
#define F_g_pf     (F.in[19])
#define F_w_gate   (F.in[20])
#define F_w_up     (F.in[21])
#define F_w_down   (F.in[22])
#define F_g_post   (F.in[23])
#define F_Win_t  ((bf16*)(F.ws + WS_WIN))
#define F_Wout_t ((bf16*)(F.ws + WS_WOUT))
#define F_Wgu_t  ((bf16*)(F.ws + WS_WGU))
#define F_Wd_t   ((bf16*)(F.ws + WS_WD))
#define F_PROJ   ((bf16*)(F.ws + WS_PROJ))
#define F_XN     ((bf16*)(F.ws + WS_XN))
#define F_YMIX   ((bf16*)(F.ws + WS_YMIX))
#define F_HID    ((bf16*)(F.ws + WS_HID))
#define F_MIXF   ((bf16*)(F.ws + WS_MIXF))
#define F_DTV    ((float*)(F.ws + WS_DTV))
#define F_PART   ((float*)(F.ws + WS_PART))

__device__ __forceinline__ float wave_sum(float v) {
#pragma unroll
    for (int o = 1; o < 64; o <<= 1) v += __shfl_xor(v, o);
    return v;
}
__device__ __forceinline__ float bf2f(bf16 h) { return __builtin_bit_cast(float, (unsigned)h << 16); }
__device__ __forceinline__ float bflo(unsigned w) { return __builtin_bit_cast(float, w << 16); }
__device__ __forceinline__ float bfhi(unsigned w) { return __builtin_bit_cast(float, w & 0xffff0000u); }
__device__ __forceinline__ float sigmoidf_(float v) { return 1.0f / (1.0f + expf(-v)); }
__device__ __forceinline__ float siluf_(float v) { return v / (1.0f + expf(-v)); }
__device__ __forceinline__ float softplusf_(float v) { return fmaxf(v, 0.f) + log1pf(expf(-fabsf(v))); }
__device__ __forceinline__ float gelu_tanhf_(float v) { const float c = 0.7978845608028654f; return 0.5f * v * (1.0f + tanhf(c * (v + 0.044715f * v * v * v))); }

__device__ __forceinline__ void p0_transpose_item(const float* W, int ldw, int Kdst, int k0, int n0, bf16* WT, int drow0, LAS float* scr, int lane) {
#pragma unroll 8
    for (int i = 0; i < 32; ++i) { const int kk = 2 * i + (lane >> 5); scr[kk * 33 + (lane & 31)] = W[(size_t)(k0 + kk) * ldw + n0 + (lane & 31)]; }
    LDS_WAIT(); asm volatile("" ::: "memory");
    const int c = lane & 7;
#pragma unroll
    for (int j = 0; j < 4; ++j) { const int n = (lane >> 3) + 8 * j; const LAS float* s = scr + (8 * c) * 33 + n;
        v4u o; o.x = pk2(s[0 * 33], s[1 * 33]); o.y = pk2(s[2 * 33], s[3 * 33]); o.z = pk2(s[4 * 33], s[5 * 33]); o.w = pk2(s[6 * 33], s[7 * 33]);
        *(GAS v4u*)(WT + (size_t)(drow0 + n) * Kdst + k0 + 8 * c) = o; }
    LDS_WAIT(); asm volatile("" ::: "memory");
}
__device__ __forceinline__ void p0_prologue(Frame& F) {
    LAS float* scr = (LAS float*)(F.lds + RING_OFF + F.wave * 16384);
    const int gw = F.vcu * NWAVES + F.wave, NGW = F.G * NWAVES;
    constexpr int I_IN = (D / 64) * (NIN / 32), I_OUT = (MIXW / 64) * (D / 32), I_G = (D / 64) * (FF / 32), I_D = (FF / 64) * (D / 32);
    constexpr int NITEMS = I_IN + I_OUT + 2 * I_G + I_D;
    for (int it = gw; it < NITEMS; it += NGW) {
        int r = it;
        if (r < I_IN) { const int nb = r % (NIN / 32), kb = r / (NIN / 32); p0_transpose_item(F_w_in, INC, D, 64 * kb, 32 * nb, F_Win_t, 32 * nb, scr, F.lane); continue; } r -= I_IN;
        if (r < I_OUT) { const int nb = r % (D / 32), kb = r / (D / 32); p0_transpose_item(F_w_out, D, MIXW, 64 * kb, 32 * nb, F_Wout_t, 32 * nb, scr, F.lane); continue; } r -= I_OUT;
        if (r < I_G) { const int nb = r % (FF / 32), kb = r / (FF / 32), n0 = 32 * nb; p0_transpose_item(F_w_gate, FF, D, 64 * kb, n0, F_Wgu_t, 256 * (n0 >> 7) + (n0 & 127), scr, F.lane); continue; } r -= I_G;
        if (r < I_G) { const int nb = r % (FF / 32), kb = r / (FF / 32), n0 = 32 * nb; p0_transpose_item(F_w_up, FF, D, 64 * kb, n0, F_Wgu_t, 256 * (n0 >> 7) + 128 + (n0 & 127), scr, F.lane); continue; } r -= I_G;
        { const int nb = r % (D / 32), kb = r / (D / 32); p0_transpose_item(F_w_down, D, FF, 64 * kb, 32 * nb, F_Wd_t, 32 * nb, scr, F.lane); }
    }
    __syncthreads();
    LAS f32x4* tbl = (LAS f32x4*)(F.lds + RING_OFF);
    for (int e = F.tid; e < 4096; e += NWAVES * 64) { const int l = e & 63, hq = (e >> 6) & 3, ci = e >> 8; const int col = 4 * l + 256 * (ci >> 2) + (ci & 3);
        const float* src = F_w_in + (size_t)col * INC + NIN + hq * 4; tbl[e] = (f32x4){src[0], src[1], src[2], src[3]}; }
    __syncthreads();
    f32x4 g[4];
#pragma unroll
    for (int j = 0; j < 4; ++j) g[j] = *(const f32x4*)(F_g_pre + 4 * F.lane + 256 * j);
    const float dtb = F_ssd_dtb[F.lane & 15];
    for (int r0 = gw * 4; r0 < M; r0 += NGW * 4) {
        f32x4 xv[4][4];
#pragma unroll
        for (int rr = 0; rr < 4; ++rr) {
            const float* xr = F_x + (size_t)(r0 + rr) * D + 4 * F.lane; float ss = 0.f;
#pragma unroll
            for (int j = 0; j < 4; ++j) { xv[rr][j] = *(const f32x4*)(xr + 256 * j); ss += (xv[rr][j].x * xv[rr][j].x + xv[rr][j].y * xv[rr][j].y) + (xv[rr][j].z * xv[rr][j].z + xv[rr][j].w * xv[rr][j].w); }
            const float rstd = 1.0f / sqrtf(wave_sum(ss) * (1.0f / D) + EPS);
            GAS unsigned long long* o8 = (GAS unsigned long long*)(F_XN + (size_t)(r0 + rr) * D) + F.lane;
#pragma unroll
            for (int j = 0; j < 4; ++j) { xv[rr][j] = xv[rr][j] * rstd * g[j];
                o8[64 * j] = (unsigned long long)pk2(xv[rr][j].x, xv[rr][j].y) | ((unsigned long long)pk2(xv[rr][j].z, xv[rr][j].w) << 32); }
        }
        float v[64];
#pragma unroll
        for (int i = 0; i < 64; ++i) v[i] = 0.f;
#pragma unroll
        for (int j = 0; j < 4; ++j)
#pragma unroll
            for (int e = 0; e < 4; ++e)
#pragma unroll
                for (int hq = 0; hq < 4; ++hq) { const f32x4 w = tbl[((j * 4 + e) * 4 + hq) * 64 + F.lane];
#pragma unroll
                    for (int rr = 0; rr < 4; ++rr) { const float xe = xv[rr][j][e];
                        v[rr * 16 + hq * 4 + 0] += xe * w.x; v[rr * 16 + hq * 4 + 1] += xe * w.y; v[rr * 16 + hq * 4 + 2] += xe * w.z; v[rr * 16 + hq * 4 + 3] += xe * w.w; }
                    if (hq == 3) asm volatile("" ::: "memory"); }
#pragma unroll
        for (int half = 32; half >= 1; half >>= 1) { const bool up = (F.lane & half) != 0;
#pragma unroll
            for (int i = 0; i < half; ++i) { const float send = up ? v[i] : v[i + half]; const float keep = up ? v[i + half] : v[i]; v[i] = keep + __shfl_xor(send, half); } }
        F_DTV[(size_t)(r0 + (F.lane >> 4)) * 16 + (F.lane & 15)] = softplusf_(v[0] + dtb);
    }
}

__device__ __forceinline__ void lru_baseline_unit(Frame& F, int unit) {
    const int b = unit >> 4, blk = unit & 15, lane = F.lane, ch = blk * 64 + lane;
    LAS float* wl = (LAS float*)(F.lds + RING_OFF);
#pragma unroll 8
    for (int i = 0; i < 64; ++i) { wl[i * 64 + lane] = F_lru_wa[blk * 4096 + i * 64 + lane]; wl[4096 + i * 64 + lane] = F_lru_wx[blk * 4096 + i * 64 + lane]; }
    LDS_WAIT(); asm volatile("" ::: "memory");
    const float ba = F_lru_ba[ch], bx = F_lru_bx[ch], sp = softplusf_(-F_lru_lam[ch]);
    const float c0 = F_lru_cw[ch], c1 = F_lru_cw[1024 + ch], c2 = F_lru_cw[2048 + ch], c3 = F_lru_cw[3072 + ch], cb = F_lru_cb[ch];
    float xm3 = 0.f, xm2 = 0.f, xm1 = 0.f, h = 0.f;
    const bf16* px = F_PROJ + (size_t)(b * T) * NIN + PC_LX + ch; const bf16* pg = F_PROJ + (size_t)(b * T) * NIN + PC_LG + ch;
    for (int t0 = 0; t0 < T; t0 += 8) {
        float xr[8], gr[8];
#pragma unroll
        for (int j = 0; j < 8; ++j) { xr[j] = bf2f(px[(size_t)(t0 + j) * NIN]); gr[j] = bf2f(pg[(size_t)(t0 + j) * NIN]); }
#pragma unroll
        for (int j = 0; j < 8; ++j) {
            const float x0 = xr[j]; const float lx = cb + c0 * xm3 + c1 * xm2 + c2 * xm1 + c3 * x0; xm3 = xm2; xm2 = xm1; xm1 = x0;
            float rp = ba, ip = bx;
#pragma unroll
            for (int i = 0; i < 64; ++i) { const float s = __builtin_bit_cast(float, __builtin_amdgcn_readlane(__builtin_bit_cast(int, lx), i)); rp = fmaf(s, wl[i * 64 + lane], rp); ip = fmaf(s, wl[4096 + i * 64 + lane], ip); }
            const float r = sigmoidf_(rp), ig = sigmoidf_(ip), la = -8.0f * r * sp, a = expf(la), mult = sqrtf(-expm1f(2.0f * la));
            h = a * h + mult * (ig * lx);
            const float y = h * gelu_tanhf_(gr[j]);
            const float ss = wave_sum(y * y);
            const size_t row = (size_t)(b * T + t0 + j);
            F_YMIX[row * MIXW + ch] = (bf16)f2bf(y);
            if (lane == 0) F_PART[row * 32 + blk] = ss;
        }
    }
}
__device__ __forceinline__ float ssd_convsilu(Frame& F, int b, int t, int c) {
    float acc = F_ssd_cb[c];
#pragma unroll
    for (int k = 0; k < 4; ++k) { const int tk = t - 3 + k; if (tk >= 0) acc += F_ssd_cw[k * XBC + c] * bf2f(F_PROJ[(size_t)(b * T + tk) * NIN + PC_X + c]); }
    return siluf_(acc);
}
__device__ __forceinline__ void ssd_baseline_unit(Frame& F, int unit) {
    const int b = unit >> 4, h = unit & 15, g = h >> 3, tid = F.tid, p = tid >> 3, nq = tid & 7;
    LAS float* Bs = (LAS float*)(F.lds + RING_OFF);
    LAS float* Cs = Bs + 32 * 128;
    LAS float* xs = Cs + 32 * 128;
    LAS float* zs = xs + 32 * 64;
    LAS float* yb = zs + 32 * 64;
    LAS float* dts = yb + 32 * 64;
    const float A = -expf(F_ssd_alog[h]), Dh = F_ssd_d[h];
    float S[16];
#pragma unroll
    for (int i = 0; i < 16; ++i) S[i] = 0.f;
    for (int t0 = 0; t0 < T; t0 += 32) {
        for (int e = tid; e < 32 * 128; e += NWAVES * 64) { const int tt = e >> 7, n = e & 127;
            Bs[e] = ssd_convsilu(F, b, t0 + tt, 1024 + g * 128 + n); Cs[e] = ssd_convsilu(F, b, t0 + tt, 1280 + g * 128 + n); }
        for (int e = tid; e < 32 * 64; e += NWAVES * 64) { const int tt = e >> 6, pp = e & 63;
            xs[e] = ssd_convsilu(F, b, t0 + tt, h * 64 + pp); zs[e] = bf2f(F_PROJ[(size_t)(b * T + t0 + tt) * NIN + PC_Z + h * 64 + pp]); }
        if (tid < 32) dts[tid] = F_DTV[(size_t)(b * T + t0 + tid) * 16 + h];
        __syncthreads();
        for (int tt = 0; tt < 32; ++tt) {
            const float dtv = dts[tt], da = expf(dtv * A), xv = xs[tt * 64 + p], dtx = dtv * xv; float yp = 0.f;
#pragma unroll
            for (int i = 0; i < 16; ++i) { const float Bv = Bs[tt * 128 + nq * 16 + i], Cv = Cs[tt * 128 + nq * 16 + i]; S[i] = S[i] * da + dtx * Bv; yp += Cv * S[i]; }
            yp += __shfl_xor(yp, 1); yp += __shfl_xor(yp, 2); yp += __shfl_xor(yp, 4);
            if (nq == 0) { const float z = zs[tt * 64 + p]; yb[tt * 64 + p] = (yp + Dh * xv) * siluf_(z); }
        }
        __syncthreads();
        for (int e = tid; e < 32 * 64; e += NWAVES * 64) { const int tt = e >> 6, pp = e & 63; F_YMIX[(size_t)(b * T + t0 + tt) * MIXW + 1024 + h * 64 + pp] = (bf16)f2bf(yb[e]); }
#pragma unroll
        for (int r = 0; r < 4; ++r) { const int tt = 4 * F.wave + r; const float v = yb[tt * 64 + F.lane]; const float ss = wave_sum(v * v);
            if (F.lane == 0) F_PART[(size_t)(b * T + t0 + tt) * 32 + 16 + h] = ss; }
        __syncthreads();
    }
}
#ifndef USE_SSD_OPT
#define USE_SSD_OPT 1
#endif
#ifndef USE_LRU_OPT
#define USE_LRU_OPT 1
#endif

typedef float f32x16 __attribute__((ext_vector_type(16)));
typedef unsigned v2u __attribute__((ext_vector_type(2)));
constexpr int TS_CC = 0, TS_BC = 32768, TS_BCT = 65536, TS_SXT = 98304, TS_XSDT = 114688, TS_S = 131072, TS_CW = 147456, TS_ARR = 153856;
static_assert(TS_ARR + 2 * 2048 <= LDSCTL_OFF, "SSD LDS map");
__device__ __forceinline__ int skey(int row) { return (row ^ (row >> 3)) & 15; }
__device__ __forceinline__ int sswz(int row, int byte) { return row * 256 + (byte ^ (skey(row) << 4)); }
#define MFMA32(a, b, c) __builtin_amdgcn_mfma_f32_32x32x16_bf16((a), (b), (c), 0, 0, 0)
__device__ __forceinline__ float fsilu(float v) { return v * __builtin_amdgcn_rcpf(1.0f + __expf(-v)); }
__device__ __forceinline__ float bfsel(const v4u& v, int e) { const unsigned d = v[e >> 1]; return (e & 1) ? bfhi(d) : bflo(d); }
#define SSD_CONV_PAIR(NT, raw, cw, chn, d, ol, oh) do { \
        const f32x2 w0_ = *(const LAS f32x2*)((cw) + 2 * (d)), w1_ = *(const LAS f32x2*)((cw) + (chn) + 2 * (d)), w2_ = *(const LAS f32x2*)((cw) + 2 * (chn) + 2 * (d)), w3_ = *(const LAS f32x2*)((cw) + 3 * (chn) + 2 * (d)), wb_ = *(const LAS f32x2*)((cw) + 4 * (chn) + 2 * (d)); \
        float lo_[(NT) + 3], hi_[(NT) + 3]; \
        _Pragma("unroll") for (int i_ = 0; i_ < (NT) + 3; ++i_) { lo_[i_] = bflo((raw)[i_][d]); hi_[i_] = bfhi((raw)[i_][d]); } \
        _Pragma("unroll") for (int j_ = 0; j_ < (NT); ++j_) { \
            ol[j_] = fsilu(wb_.x + w0_.x * lo_[j_] + w1_.x * lo_[j_ + 1] + w2_.x * lo_[j_ + 2] + w3_.x * lo_[j_ + 3]); \
            oh[j_] = fsilu(wb_.y + w0_.y * hi_[j_] + w1_.y * hi_[j_ + 1] + w2_.y * hi_[j_ + 2] + w3_.y * hi_[j_ + 3]); } } while (0)
typedef float f32x2 __attribute__((ext_vector_type(2)));
__device__ __forceinline__ void ssd_unit(Frame& F, int unit) {
    const int b = unit >> 4, h = unit & 15, g = h >> 3, tid = F.tid, lane = F.lane, w = F.wave;
    LAS unsigned char* L = F.lds;
    LAS float* cwt = (LAS float*)(L + TS_CW);
    for (int e = tid; e < 1600; e += NWAVES * 64) { int k, c; if (e < 320) { k = e >> 6; c = h * 64 + (e & 63); } else if (e < 960) { const int e2 = e - 320; k = e2 >> 7; c = 1024 + g * 128 + (e2 & 127); } else { const int e2 = e - 960; k = e2 >> 7; c = 1280 + g * 128 + (e2 & 127); }
        cwt[e] = (k < 4) ? F_ssd_cw[k * XBC + c] : F_ssd_cb[c]; }
    for (int e = tid; e < 4096; e += NWAVES * 64) ((LAS unsigned*)(L + TS_S))[e] = 0u;
    const float A = -expf(F_ssd_alog[h]), Dh = F_ssd_d[h];
    const bf16* pj = F_PROJ + (size_t)(b * T) * NIN;
    const int oB = PC_B + g * 128 + 8 * (tid & 15), oC = oB + (PC_C - PC_B), oX = PC_X + h * 64 + 8 * (tid & 7), oZ = PC_Z + h * 64 + 16 * (tid & 3);
    const float* pDT = F_DTV + (size_t)(b * T) * 16 + h;
    v4u rb[7], rc[7], rx[5], rz[2]; float dtp0 = 0.f, dtp1 = 0.f;
#define SSD_PREFETCH_BX(cc) do { const int tb_ = 128 * (cc) + 4 * (tid >> 4) - 3, tx_ = 128 * (cc) + 2 * (tid >> 3) - 3; \
        _Pragma("unroll") for (int i_ = 0; i_ < 7; ++i_) { const int t_ = tb_ + i_ < 0 ? 0 : tb_ + i_; rb[i_] = *(const GAS v4u*)(pj + (t_ * NIN + oB)); } \
        _Pragma("unroll") for (int i_ = 0; i_ < 5; ++i_) { const int t_ = tx_ + i_ < 0 ? 0 : tx_ + i_; rx[i_] = *(const GAS v4u*)(pj + (t_ * NIN + oX)); } \
        if (w == 0) { dtp0 = pDT[(size_t)(128 * (cc) + 2 * lane) * 16]; dtp1 = pDT[(size_t)(128 * (cc) + 2 * lane + 1) * 16]; } } while (0)
#define SSD_PREFETCH_C(cc) do { const int tb_ = 128 * (cc) + 4 * (tid >> 4) - 3; \
        _Pragma("unroll") for (int i_ = 0; i_ < 7; ++i_) { const int t_ = tb_ + i_ < 0 ? 0 : tb_ + i_; rc[i_] = *(const GAS v4u*)(pj + (t_ * NIN + oC)); } } while (0)
#define SSD_CUMSUM(par) do { LAS float* a_ = (LAS float*)(L + TS_ARR + (par) * 2048); const float a0_ = dtp0 * A, a1_ = dtp1 * A; float in_ = a0_ + a1_; \
        _Pragma("unroll") for (int d_ = 1; d_ < 64; d_ <<= 1) { const float t_ = __shfl_up(in_, d_); if (lane >= d_) in_ += t_; } \
        float ex_ = __shfl_up(in_, 1); if (lane == 0) ex_ = 0.f; const float cs0_ = ex_ + a0_, cs1_ = in_, ce_ = __shfl(in_, 63); \
        a_[2 * lane] = dtp0; a_[2 * lane + 1] = dtp1; a_[128 + 2 * lane] = cs0_; a_[129 + 2 * lane] = cs1_; a_[256 + 2 * lane] = __expf(cs0_); a_[257 + 2 * lane] = __expf(cs1_); \
        a_[384 + 2 * lane] = dtp0 * __expf(ce_ - cs0_); a_[385 + 2 * lane] = dtp1 * __expf(ce_ - cs1_); } while (0)
    SSD_PREFETCH_BX(0); SSD_PREFETCH_C(0);
    if (w == 0) SSD_CUMSUM(0);
    f32x16 Sacc;
#pragma unroll
    for (int i = 0; i < 16; ++i) Sacc[i] = 0.f;
    LDS_WAIT(); __syncthreads();
    const int s0 = 32 * (w >> 1), l0 = 64 * (w & 1), l0y = 32 * (w >> 1), p0 = 32 * (w & 1), n0 = l0y;
    for (int c = 0; c < 64; ++c) {
        const LAS float* dtl = (const LAS float*)(L + TS_ARR + (c & 1) * 2048); const LAS float* csl = dtl + 128; const LAS float* ecs = dtl + 256; const LAS float* wl = dtl + 384;
        int tq = tid; asm volatile("" : "+v"(tq));
        const int co = tq & 15, q = tq >> 4, cx = tq & 7, qx = tq >> 3;
        {   if (c == 0 && q == 0) {
#pragma unroll
                for (int i = 0; i < 3; ++i) { rb[i] = (v4u){0u, 0u, 0u, 0u}; rc[i] = (v4u){0u, 0u, 0u, 0u}; } }
            v4u rowpk[4];
#pragma unroll
            for (int d = 0; d < 4; ++d) { float ol_[4], oh_[4]; SSD_CONV_PAIR(4, rb, cwt + 320 + 8 * co, 128, d, ol_, oh_);
#pragma unroll
                for (int j = 0; j < 4; ++j) rowpk[j][d] = pk2(ol_[j], oh_[j]);
                v2u t0; t0.x = pk2(ol_[0], ol_[1]); t0.y = pk2(ol_[2], ol_[3]); *(LAS v2u*)(L + TS_BCT + sswz(8 * co + 2 * d, 8 * q)) = t0;
                v2u t1; t1.x = pk2(oh_[0], oh_[1]); t1.y = pk2(oh_[2], oh_[3]); *(LAS v2u*)(L + TS_BCT + sswz(8 * co + 2 * d + 1, 8 * q)) = t1; }
#pragma unroll
            for (int j = 0; j < 4; ++j) *(LAS v4u*)(L + TS_BC + sswz(4 * q + j, 16 * co)) = rowpk[j];
            __builtin_amdgcn_sched_barrier(0);
#pragma unroll
            for (int d = 0; d < 4; ++d) { float ol_[4], oh_[4]; SSD_CONV_PAIR(4, rc, cwt + 960 + 8 * co, 128, d, ol_, oh_);
#pragma unroll
                for (int j = 0; j < 4; ++j) rowpk[j][d] = pk2(ol_[j], oh_[j]); }
#pragma unroll
            for (int j = 0; j < 4; ++j) *(LAS v4u*)(L + TS_CC + sswz(4 * q + j, 16 * co)) = rowpk[j];
        }
        __builtin_amdgcn_sched_barrier(0);
        {   if (c == 0 && qx < 2) {
#pragma unroll
                for (int i = 0; i < 3; ++i) if (2 * qx - 3 + i < 0) rx[i] = (v4u){0u, 0u, 0u, 0u}; }
            const float w0 = wl[2 * qx], w1 = wl[2 * qx + 1];
#pragma unroll
            for (int d = 0; d < 4; ++d) { float ol_[2], oh_[2]; SSD_CONV_PAIR(2, rx, cwt + 8 * cx, 64, d, ol_, oh_);
                *(LAS unsigned*)(L + TS_SXT + sswz(8 * cx + 2 * d, 4 * qx)) = pk2(ol_[0], ol_[1]); *(LAS unsigned*)(L + TS_XSDT + sswz(8 * cx + 2 * d, 4 * qx)) = pk2(ol_[0] * w0, ol_[1] * w1);
                *(LAS unsigned*)(L + TS_SXT + sswz(8 * cx + 2 * d + 1, 4 * qx)) = pk2(oh_[0], oh_[1]); *(LAS unsigned*)(L + TS_XSDT + sswz(8 * cx + 2 * d + 1, 4 * qx)) = pk2(oh_[0] * w0, oh_[1] * w1); }
        }
        __builtin_amdgcn_sched_barrier(0);
        __builtin_amdgcn_sched_barrier(0);
        const int cn = c < 63 ? c + 1 : 63; SSD_PREFETCH_BX(cn);
        rz[0] = *(const GAS v4u*)(pj + ((128 * c + (tid >> 2)) * NIN + oZ)); rz[1] = *(const GAS v4u*)(pj + ((128 * c + (tid >> 2)) * NIN + oZ + 8));
        LDS_WAIT(); __syncthreads();
        int tm = tid; asm volatile("" : "+v"(tm)); const int r = tm & 31, hh = (tm >> 5) & 1;
        f32x16 sc0, sc1, yacc;
#pragma unroll
        for (int i = 0; i < 16; ++i) { sc0[i] = 0.f; sc1[i] = 0.f; yacc[i] = 0.f; }
        {   const int ra = s0 + r, rb0 = l0 + r, rb1 = l0 + 32 + r;
            const int ba = TS_BC + ra * 256, ka = skey(ra) ^ hh, bb0 = TS_CC + rb0 * 256, kb0 = skey(rb0) ^ hh, bb1 = TS_CC + rb1 * 256, kb1 = skey(rb1) ^ hh;
#pragma unroll
            for (int ks = 0; ks < 8; ++ks) { const bf16x8 a = *(const LAS bf16x8*)(L + ba + (((2 * ks) ^ ka) << 4));
                const bf16x8 f0 = *(const LAS bf16x8*)(L + bb0 + (((2 * ks) ^ kb0) << 4)), f1 = *(const LAS bf16x8*)(L + bb1 + (((2 * ks) ^ kb1) << 4));
                sc0 = MFMA32(a, f0, sc0); sc1 = MFMA32(a, f1, sc1); if (ks & 1) __builtin_amdgcn_sched_barrier(0); }
        }
        const int ry = l0y + r, byA = ry * 256, kyA = skey(ry) ^ hh;
        const int rp = p0 + r, bpB = rp * 256, kpB = skey(rp) ^ hh;
#pragma unroll
        for (int ks = 0; ks < 8; ++ks) { const bf16x8 a = *(const LAS bf16x8*)(L + TS_CC + byA + (((2 * ks) ^ kyA) << 4)), f = *(const LAS bf16x8*)(L + TS_S + bpB + (((2 * ks) ^ kpB) << 4));
            yacc = MFMA32(a, f, yacc); if ((ks & 3) == 3) __builtin_amdgcn_sched_barrier(0); }
#pragma unroll
        for (int q4 = 0; q4 < 4; ++q4) { const f32x4 e4 = *(const LAS f32x4*)(ecs + l0y + 8 * q4 + 4 * hh);
            yacc[4 * q4 + 0] *= e4.x; yacc[4 * q4 + 1] *= e4.y; yacc[4 * q4 + 2] *= e4.z; yacc[4 * q4 + 3] *= e4.w; }
        LDS_WAIT(); __syncthreads();
#pragma unroll
        for (int j = 0; j < 2; ++j) { const int l = l0 + 32 * j + r; const float cl = csl[l];
#pragma unroll
            for (int q4 = 0; q4 < 4; ++q4) { const int sb = s0 + 8 * q4 + 4 * hh; const f32x4 cs4 = *(const LAS f32x4*)(csl + sb), dt4 = *(const LAS f32x4*)(dtl + sb); float m[4];
#pragma unroll
                for (int i = 0; i < 4; ++i) { const float sv = j ? sc1[4 * q4 + i] : sc0[4 * q4 + i]; const float v = sv * __expf(cl - cs4[i]) * dt4[i]; m[i] = (l >= sb + i) ? v : 0.f; }
                v2u pk; pk.x = pk2(m[0], m[1]); pk.y = pk2(m[2], m[3]); *(LAS v2u*)(L + TS_CC + sswz(l, 2 * sb)) = pk; } }
        SSD_PREFETCH_C(cn);
        LDS_WAIT(); __syncthreads();
#pragma unroll
        for (int ks = 0; ks < 8; ++ks) { const bf16x8 a = *(const LAS bf16x8*)(L + TS_CC + byA + (((2 * ks) ^ kyA) << 4)), f = *(const LAS bf16x8*)(L + TS_SXT + bpB + (((2 * ks) ^ kpB) << 4));
            yacc = MFMA32(a, f, yacc); if ((ks & 3) == 3) __builtin_amdgcn_sched_barrier(0); }
        { const float dec = ecs[127];
#pragma unroll
            for (int i = 0; i < 16; ++i) Sacc[i] *= dec; }
#pragma unroll
        for (int ks = 0; ks < 8; ++ks) { const bf16x8 a = *(const LAS bf16x8*)(L + TS_BCT + byA + (((2 * ks) ^ kyA) << 4)), f = *(const LAS bf16x8*)(L + TS_XSDT + bpB + (((2 * ks) ^ kpB) << 4));
            Sacc = MFMA32(a, f, Sacc); if ((ks & 3) == 3) __builtin_amdgcn_sched_barrier(0); }
#pragma unroll
        for (int q4 = 0; q4 < 4; ++q4) { const int lb = l0y + 8 * q4 + 4 * hh; const v2u sw = *(const LAS v2u*)(L + TS_SXT + sswz(rp, 2 * lb));
            yacc[4 * q4 + 0] += Dh * bflo(sw.x); yacc[4 * q4 + 1] += Dh * bfhi(sw.x); yacc[4 * q4 + 2] += Dh * bflo(sw.y); yacc[4 * q4 + 3] += Dh * bfhi(sw.y); }
        int t5 = tid; asm volatile("" : "+v"(t5)); const int r5 = t5 & 31, h5 = (t5 >> 5) & 1, rp5 = p0 + r5;
#pragma unroll
        for (int i = 0; i < 16; ++i) { const int l = l0y + (i & 3) + 8 * (i >> 2) + 4 * h5; *(LAS float*)(L + TS_BC + l * 256 + ((((rp5 >> 2) ^ skey(l)) & 15) << 4) + (rp5 & 3) * 4) = yacc[i]; }
#pragma unroll
        for (int q4 = 0; q4 < 4; ++q4) { const int nb = n0 + 8 * q4 + 4 * h5; v2u pk; pk.x = pk2(Sacc[4 * q4], Sacc[4 * q4 + 1]); pk.y = pk2(Sacc[4 * q4 + 2], Sacc[4 * q4 + 3]); *(LAS v2u*)(L + TS_S + sswz(rp5, 2 * nb)) = pk; }
        LDS_WAIT(); __syncthreads();
        {   int to = tid; asm volatile("" : "+v"(to)); const int ol = to >> 2, opq = to & 3;
            float yv[16], zf[16];
#pragma unroll
            for (int i = 0; i < 4; ++i) { const f32x4 t4 = *(const LAS f32x4*)(L + TS_BC + ol * 256 + ((((4 * opq + i) ^ skey(ol)) & 15) << 4)); yv[4 * i] = t4.x; yv[4 * i + 1] = t4.y; yv[4 * i + 2] = t4.z; yv[4 * i + 3] = t4.w; }
#pragma unroll
            for (int e = 0; e < 8; ++e) { zf[e] = bfsel(rz[0], e); zf[8 + e] = bfsel(rz[1], e); }
            float ss = 0.f;
#pragma unroll
            for (int k = 0; k < 16; ++k) { yv[k] = yv[k] * fsilu(zf[k]); ss += yv[k] * yv[k]; }
            ss += __shfl_xor(ss, 1); ss += __shfl_xor(ss, 2);
            const size_t row = (size_t)(b * T + 128 * c + ol);
            v4u o0, o1; o0.x = pk2(yv[0], yv[1]); o0.y = pk2(yv[2], yv[3]); o0.z = pk2(yv[4], yv[5]); o0.w = pk2(yv[6], yv[7]); o1.x = pk2(yv[8], yv[9]); o1.y = pk2(yv[10], yv[11]); o1.z = pk2(yv[12], yv[13]); o1.w = pk2(yv[14], yv[15]);
            GAS v4u* op = (GAS v4u*)(F_YMIX + row * MIXW + 1024 + h * 64 + 16 * opq); op[0] = o0; op[1] = o1;
            if (opq == 0) F_PART[row * 32 + 16 + h] = ss;
        }
        if (w == 0) SSD_CUMSUM((c + 1) & 1);
        LDS_WAIT(); __syncthreads();
    }
#undef SSD_PREFETCH_BX
#undef SSD_PREFETCH_C
#undef SSD_CUMSUM
}

constexpr int TL_LXA = 0, TL_G = 32768, TL_Y = 65536, TL_COMP = 98304, TL_CW = 102400, TL_WF = 106496;
#define LRU_CONV_PAIR(raw, cw, d, ol, oh) do { \
        const f32x2 w0_ = *(const LAS f32x2*)((cw) + 2 * (d)), w1_ = *(const LAS f32x2*)((cw) + 64 + 2 * (d)), w2_ = *(const LAS f32x2*)((cw) + 128 + 2 * (d)), w3_ = *(const LAS f32x2*)((cw) + 192 + 2 * (d)), wb_ = *(const LAS f32x2*)((cw) + 256 + 2 * (d)); \
        float lo_[7], hi_[7]; \
        _Pragma("unroll") for (int i_ = 0; i_ < 7; ++i_) { lo_[i_] = bflo((raw)[i_][d]); hi_[i_] = bfhi((raw)[i_][d]); } \
        _Pragma("unroll") for (int j_ = 0; j_ < 4; ++j_) { \
            ol[j_] = wb_.x + w0_.x * lo_[j_] + w1_.x * lo_[j_ + 1] + w2_.x * lo_[j_ + 2] + w3_.x * lo_[j_ + 3]; \
            oh[j_] = wb_.y + w0_.y * hi_[j_] + w1_.y * hi_[j_ + 1] + w2_.y * hi_[j_ + 2] + w3_.y * hi_[j_ + 3]; } } while (0)
__device__ __forceinline__ float fsigmoid(float v) { return __builtin_amdgcn_rcpf(1.0f + __expf(-v)); }
__device__ __forceinline__ void lru_unit(Frame& F, int unit) {
    const int b = unit >> 4, blk = unit & 15, tid = F.tid, lane = F.lane, w = F.wave;
    LAS unsigned char* L = F.lds;
    LAS float* cwt = (LAS float*)(L + TL_CW);
    for (int e = tid; e < 320; e += NWAVES * 64) { const int k = e >> 6, ch = blk * 64 + (e & 63); cwt[e] = (k < 4) ? F_lru_cw[k * 1024 + ch] : F_lru_cb[ch]; }
    {   const int r = lane & 31, hh = lane >> 5;
        for (int f = w; f < 16; f += NWAVES) { const int m = f >> 3, jb = (f >> 2) & 1, ks = f & 3; const float* s = (m ? F_lru_wx : F_lru_wa) + blk * 4096 + (16 * ks + 8 * hh) * 64 + 32 * jb + r;
            v4u pk; pk.x = pk2(s[0], s[64]); pk.y = pk2(s[128], s[192]); pk.z = pk2(s[256], s[320]); pk.w = pk2(s[384], s[448]);
            *(LAS v4u*)(L + TL_WF + f * 1024 + lane * 16) = pk; }
    }
    float ba[2], bx[2], sp8[2], hcar[2];
#pragma unroll
    for (int jb = 0; jb < 2; ++jb) { const int ch = blk * 64 + 32 * jb + (lane & 31); ba[jb] = F_lru_ba[ch]; bx[jb] = F_lru_bx[ch]; sp8[jb] = -8.0f * softplusf_(-F_lru_lam[ch]); hcar[jb] = 0.f; }
    const bf16* pj = F_PROJ + (size_t)(b * T) * NIN;
    const int oX = PC_LX + blk * 64 + 8 * (tid & 7), oG = PC_LG + blk * 64 + 8 * (tid & 7);
    v4u rxl[7], rg[4];
#define LRU_PREFETCH(cc) do { const int tb_ = 256 * (cc) + 4 * (tid >> 3) - 3; \
        _Pragma("unroll") for (int i_ = 0; i_ < 7; ++i_) { const int t_ = tb_ + i_ < 0 ? 0 : tb_ + i_; rxl[i_] = *(const GAS v4u*)(pj + (t_ * NIN + oX)); } \
        _Pragma("unroll") for (int i_ = 0; i_ < 4; ++i_) rg[i_] = *(const GAS v4u*)(pj + ((tb_ + 3 + i_) * NIN + oG)); } while (0)
    LRU_PREFETCH(0);
    LDS_WAIT(); __syncthreads();
    for (int c = 0; c < 32; ++c) {
        {   int tq = tid; asm volatile("" : "+v"(tq)); const int co = tq & 7, q = tq >> 3;
            if (c == 0 && q == 0) {
#pragma unroll
                for (int i = 0; i < 3; ++i) rxl[i] = (v4u){0u, 0u, 0u, 0u}; }
            v4u rowpk[4];
#pragma unroll
            for (int d = 0; d < 4; ++d) { float ol_[4], oh_[4]; LRU_CONV_PAIR(rxl, cwt + 8 * co, d, ol_, oh_);
#pragma unroll
                for (int j = 0; j < 4; ++j) rowpk[j][d] = pk2(ol_[j], oh_[j]); }
#pragma unroll
            for (int j = 0; j < 4; ++j) { const int row = 4 * q + j; *(LAS v4u*)(L + TL_LXA + row * 128 + ((co ^ ((row >> 1) & 7)) << 4)) = rowpk[j]; *(LAS v4u*)(L + TL_G + row * 128 + co * 16) = rg[j]; }
        }
        __builtin_amdgcn_sched_barrier(0);
        { const int cn = c < 31 ? c + 1 : 31; LRU_PREFETCH(cn); }
        LDS_WAIT(); __syncthreads();
        int tm = tid; asm volatile("" : "+v"(tm)); const int r = tm & 31, hh = (tm >> 5) & 1;
        f32x16 accR[2], accI[2];
#pragma unroll
        for (int jb = 0; jb < 2; ++jb)
#pragma unroll
            for (int i = 0; i < 16; ++i) { accR[jb][i] = 0.f; accI[jb][i] = 0.f; }
        {   const int row = 32 * w + r, base = TL_LXA + row * 128, ka = ((row >> 1) & 7) ^ hh;
#pragma unroll
            for (int ks = 0; ks < 4; ++ks) { const bf16x8 a = *(const LAS bf16x8*)(L + base + (((2 * ks) ^ ka) << 4));
                const LAS unsigned char* wb = L + TL_WF + ks * 1024 + (tm & 63) * 16;
                accR[0] = MFMA32(a, *(const LAS bf16x8*)(wb), accR[0]); accR[1] = MFMA32(a, *(const LAS bf16x8*)(wb + 4096), accR[1]);
                accI[0] = MFMA32(a, *(const LAS bf16x8*)(wb + 8192), accI[0]); accI[1] = MFMA32(a, *(const LAS bf16x8*)(wb + 12288), accI[1]); }
        }
        float eA[2][4], eH[2][4];
#pragma unroll
        for (int jb = 0; jb < 2; ++jb) { const int ch = 32 * jb + r; float gA[4], gH[4];
#pragma unroll
            for (int qg = 0; qg < 4; ++qg) { float hp = 0.f, pp = 1.f;
#pragma unroll
                for (int i = 0; i < 4; ++i) { const int reg = 4 * qg + i, t = 32 * w + 8 * qg + 4 * hh + i;
                    const float rr = fsigmoid(accR[jb][reg] + ba[jb]), ii = fsigmoid(accI[jb][reg] + bx[jb]);
                    const float a = __expf(sp8[jb] * rr), mult = __builtin_amdgcn_sqrtf(fmaxf(1.0f - a * a, 0.f));
                    const float lx = bf2f(*(const LAS bf16*)(L + TL_LXA + t * 128 + ((((ch >> 3) ^ ((t >> 1) & 7))) << 4) + (ch & 7) * 2));
                    hp = a * hp + mult * (ii * lx); pp = a * pp; accR[jb][reg] = hp; accI[jb][reg] = pp; }
                gA[qg] = pp; gH[qg] = hp; }
            float cA = 1.f, cH = 0.f;
#pragma unroll
            for (int qg = 0; qg < 4; ++qg) { const float pA = __shfl_xor(gA[qg], 32), pH = __shfl_xor(gH[qg], 32);
                const float A1 = hh ? pA : gA[qg], H1 = hh ? pH : gH[qg], A2 = hh ? gA[qg] : pA, H2 = hh ? gH[qg] : pH;
                const float bA = cA, bH = cH; cH = A1 * cH + H1; cA = A1 * cA; const float mA = cA, mH = cH; cH = A2 * cH + H2; cA = A2 * cA;
                eA[jb][qg] = hh ? mA : bA; eH[jb][qg] = hh ? mH : bH; }
            if (hh == 0) { LAS float* cp = (LAS float*)(L + TL_COMP) + (w * 64 + ch) * 2; cp[0] = cA; cp[1] = cH; }
        }
        LDS_WAIT(); __syncthreads();
#pragma unroll
        for (int jb = 0; jb < 2; ++jb) { const int ch = 32 * jb + r; float run = hcar[jb], cin = 0.f;
#pragma unroll
            for (int wp = 0; wp < 8; ++wp) { const f32x2 cm = *(const LAS f32x2*)((const LAS float*)(L + TL_COMP) + (wp * 64 + ch) * 2); if (wp == w) cin = run; run = cm.x * run + cm.y; }
            hcar[jb] = run;
#pragma unroll
            for (int qg = 0; qg < 4; ++qg) { const float cg = eA[jb][qg] * cin + eH[jb][qg];
#pragma unroll
                for (int i = 0; i < 4; ++i) { const int reg = 4 * qg + i, t = 32 * w + 8 * qg + 4 * hh + i;
                    const float hv = accR[jb][reg] + accI[jb][reg] * cg;
                    const float gt = bf2f(*(const LAS bf16*)(L + TL_G + t * 128 + ch * 2));
                    const float z2 = 1.5957691216057308f * (gt + 0.044715f * gt * gt * gt);
                    const float y = hv * gt * fsigmoid(z2);
                    *(LAS bf16*)(L + TL_Y + t * 128 + ch * 2) = (bf16)f2bf(y); } }
        }
        LDS_WAIT(); __syncthreads();
        {   int to = tid; asm volatile("" : "+v"(to)); const int t = to >> 1, hf = to & 1;
            const LAS v4u* yp = (const LAS v4u*)(L + TL_Y + t * 128 + hf * 64); v4u yv[4]; float ss = 0.f;
#pragma unroll
            for (int i = 0; i < 4; ++i) { yv[i] = yp[i];
#pragma unroll
                for (int d = 0; d < 4; ++d) { const float lo = bflo(yv[i][d]), hi = bfhi(yv[i][d]); ss += lo * lo + hi * hi; } }
            ss += __shfl_xor(ss, 1);
            const size_t row = (size_t)(b * T + 256 * c + t);
            GAS v4u* op = (GAS v4u*)(F_YMIX + row * MIXW + blk * 64 + 32 * hf);
#pragma unroll
            for (int i = 0; i < 4; ++i) op[i] = yv[i];
            if (hf == 0) F_PART[row * 32 + blk] = ss;
        }
    }
    __syncthreads();
#undef LRU_PREFETCH
}

template <bool DO_SSD, bool DO_LRU> __device__ __forceinline__ void p2_mixer(Frame& F) {
    const int i = F.vcu;
    if (i < 256) { const int unit = (i >> 5) * 16 + (i & 15);
        if ((i & 31) < 16) { if (DO_SSD) {
#if USE_SSD_OPT
            ssd_unit(F, unit);
#else
            ssd_baseline_unit(F, unit);
#endif
        } } else if (DO_LRU) {
#if USE_LRU_OPT == 1
            lru_unit(F, unit);
#elif USE_LRU_OPT == 2
            (void)unit;
#else
            if (F.wave == 0) lru_baseline_unit(F, unit);
#endif
        }
    }
}
__device__ __forceinline__ void p3_ymix_norm(Frame& F) {
    const int gw = F.vcu * NWAVES + F.wave, NGW = F.G * NWAVES, lane = F.lane;
    float gn[4][8];
#pragma unroll
    for (int j = 0; j < 4; ++j)
#pragma unroll
        for (int e = 0; e < 8; ++e) { const int c = 8 * lane + 512 * j + e; gn[j][e] = (j < 2) ? F_g_lru[c] : F_g_ssd[c - 1024]; }
    for (int row = gw; row < M; row += NGW) {
        float s = F_PART[(size_t)row * 32 + (lane & 31)];
        s += __shfl_xor(s, 1); s += __shfl_xor(s, 2); s += __shfl_xor(s, 4); s += __shfl_xor(s, 8);
        const float sl = __shfl(s, 0), ssd = __shfl(s, 16);
        const float rl = 1.0f / sqrtf(sl * (1.0f / 1024.0f) + EPS), rs = 1.0f / sqrtf(ssd * (1.0f / 1024.0f) + EPS);
        GAS v4u* yp = (GAS v4u*)(F_YMIX + (size_t)row * MIXW) + lane;
#pragma unroll
        for (int j = 0; j < 4; ++j) { const v4u w = yp[64 * j]; const float sc = (j < 2) ? rl : rs; v4u o;
            o.x = pk2(bflo(w.x) * sc * gn[j][0], bfhi(w.x) * sc * gn[j][1]); o.y = pk2(bflo(w.y) * sc * gn[j][2], bfhi(w.y) * sc * gn[j][3]);
            o.z = pk2(bflo(w.z) * sc * gn[j][4], bfhi(w.z) * sc * gn[j][5]); o.w = pk2(bflo(w.w) * sc * gn[j][6], bfhi(w.w) * sc * gn[j][7]);
            yp[64 * j] = o; }
    }
}
__device__ __forceinline__ void p5_post_mix(Frame& F) {
    const int gw = F.vcu * NWAVES + F.wave, NGW = F.G * NWAVES, lane = F.lane;
    f32x4 gm[4], gf[4];
#pragma unroll
    for (int j = 0; j < 4; ++j) { gm[j] = *(const f32x4*)(F_g_pm + 4 * lane + 256 * j); gf[j] = *(const f32x4*)(F_g_pf + 4 * lane + 256 * j); }
    for (int row = gw; row < M; row += NGW) {
        const GAS unsigned long long* mp = (const GAS unsigned long long*)(F_MIXF + (size_t)row * D) + lane;
        const GAS f32x4* xp = (const GAS f32x4*)(F_x + (size_t)row * D) + lane;
        f32x4 mv[4], xv[4]; float ss = 0.f;
#pragma unroll
        for (int j = 0; j < 4; ++j) { const unsigned long long w = mp[64 * j]; const unsigned lo = (unsigned)w, hi = (unsigned)(w >> 32);
            mv[j] = (f32x4){bflo(lo), bfhi(lo), bflo(hi), bfhi(hi)}; xv[j] = xp[64 * j];
            ss += (mv[j].x * mv[j].x + mv[j].y * mv[j].y) + (mv[j].z * mv[j].z + mv[j].w * mv[j].w); }
        const float rm = 1.0f / sqrtf(wave_sum(ss) * (1.0f / D) + EPS);
        float s1 = 0.f;
        GAS f32x4* op = (GAS f32x4*)(F.out + (size_t)row * D) + lane;
#pragma unroll
        for (int j = 0; j < 4; ++j) { xv[j] = xv[j] + mv[j] * rm * gm[j]; op[64 * j] = xv[j];
            s1 += (xv[j].x * xv[j].x + xv[j].y * xv[j].y) + (xv[j].z * xv[j].z + xv[j].w * xv[j].w); }
        const float r1 = 1.0f / sqrtf(wave_sum(s1) * (1.0f / D) + EPS);
        GAS unsigned long long* hp = (GAS unsigned long long*)(F_XN + (size_t)row * D) + lane;
#pragma unroll
        for (int j = 0; j < 4; ++j) { const f32x4 hv = xv[j] * r1 * gf[j]; hp[64 * j] = (unsigned long long)pk2(hv.x, hv.y) | ((unsigned long long)pk2(hv.z, hv.w) << 32); }
    }
}
__device__ __forceinline__ void p8_post_ffn(Frame& F) {
    const int gw = F.vcu * NWAVES + F.wave, NGW = F.G * NWAVES, lane = F.lane;
    f32x4 gp[4];
#pragma unroll
    for (int j = 0; j < 4; ++j) gp[j] = *(const f32x4*)(F_g_post + 4 * lane + 256 * j);
    for (int row = gw; row < M; row += NGW) {
        const GAS unsigned long long* mp = (const GAS unsigned long long*)(F_MIXF + (size_t)row * D) + lane;
        GAS f32x4* op = (GAS f32x4*)(F.out + (size_t)row * D) + lane;
        f32x4 mv[4], xv[4]; float ss = 0.f;
#pragma unroll
        for (int j = 0; j < 4; ++j) { const unsigned long long w = mp[64 * j]; const unsigned lo = (unsigned)w, hi = (unsigned)(w >> 32);
            mv[j] = (f32x4){bflo(lo), bfhi(lo), bflo(hi), bfhi(hi)}; xv[j] = op[64 * j];
            ss += (mv[j].x * mv[j].x + mv[j].y * mv[j].y) + (mv[j].z * mv[j].z + mv[j].w * mv[j].w); }
        const float rm = 1.0f / sqrtf(wave_sum(ss) * (1.0f / D) + EPS);
#pragma unroll
        for (int j = 0; j < 4; ++j) op[64 * j] = xv[j] + mv[j] * rm * gp[j];
    }
}

struct Args { const float* in[24]; float* out; unsigned char* ws; int ph_lo, ph_hi, li, pad; };
template <unsigned MASK> __global__ void __launch_bounds__(NWAVES * 64, 2) hyb_fwd(Args args) {
    extern __shared__ __attribute__((aligned(16))) unsigned char lds[];
    Frame F;
    F.lds = (LAS unsigned char*)lds;
    F.MISC = (volatile LAS unsigned*)(F.lds + MISC_OFF);
    F.tid = threadIdx.x; F.lane = F.tid & 63; F.wave = __builtin_amdgcn_readfirstlane(F.tid >> 6);
    F.G = gridDim.x; { const int bx = blockIdx.x; F.vcu = (F.G % 8 == 0) ? (bx % 8) * (F.G / 8) + bx / 8 : bx; }
    unsigned char* ws = args.ws;
    F.ctl = (gu32*)(ws + WS_CTL);
    F.in = args.in; F.out = args.out; F.ws = ws;
    for (int u = F.tid; u < (LDS_BYTES - LDSCTL_OFF) / 4; u += NWAVES * 64) ((LAS unsigned*)(F.lds + LDSCTL_OFF))[u] = 0u;
    __syncthreads();
    XcdBarrier bar; bar.bar = (unsigned*)(F.ctl + CW_BAR); bar.x = 0; bar.st = nullptr;
    if (N_LAUNCHES == 1) bar = xcd_barrier_post((unsigned*)(F.ctl + CW_BAR), F.MISC + 8);
#define GRID_BAR() do { if (N_LAUNCHES == 1) xcd_barrier(bar); } while (0)
    const int lo = args.ph_lo, hi = args.ph_hi;
#define IN(k) (((MASK >> (k)) & 1u) && lo <= (k) && (k) < hi)
#define BOTH(k) (IN(k) && IN((k) + 1))

    if (IN(0)) { p0_prologue(F); if (BOTH(0)) GRID_BAR(); }
    if (IN(1)) {
        pg8::Gemm g{F_XN, F_Win_t, M, NIN, D}; pg8::StaticOrder S; S.init(M, NIN, F.G, (int)blockIdx.x);
        pg8::EpiBf16<0> E{F_PROJ, NIN, nullptr, 0, 0, 1.f};
        pg8::gemm_phase<pg8::EpiBf16<0>, pg8::StaticOrder, PG8_ALIGN, PG8_SP2>(F.lds + RING_OFF, g, S, E);
        if (BOTH(1)) GRID_BAR();
    }
    if (IN(2)) { p2_mixer<!((MASK >> 16) & 1u), !((MASK >> 17) & 1u)>(F); if (BOTH(2)) GRID_BAR(); }
    if (IN(3)) { p3_ymix_norm(F); if (BOTH(3)) GRID_BAR(); }
    if (IN(4)) {
        pg8::Gemm g{F_YMIX, F_Wout_t, M, D, MIXW}; pg8::StaticOrder S; S.init(M, D, F.G, (int)blockIdx.x);
        pg8::EpiBf16<0> E{F_MIXF, D, nullptr, 0, 0, 1.f};
        pg8::gemm_phase<pg8::EpiBf16<0>, pg8::StaticOrder, PG8_ALIGN, PG8_SP2>(F.lds + RING_OFF, g, S, E);
        if (BOTH(4)) GRID_BAR();
    }
    if (IN(5)) { p5_post_mix(F); if (BOTH(5)) GRID_BAR(); }
    if (IN(6)) {
        pg8::Gemm g{F_XN, F_Wgu_t, M, NGU, D}; pg8::StaticOrder S; S.init(M, NGU, F.G, (int)blockIdx.x);
        pg8::EpiSwiGLU E{F_HID, FF};
        pg8::gemm_phase<pg8::EpiSwiGLU, pg8::StaticOrder, PG8_ALIGN, PG8_SP2>(F.lds + RING_OFF, g, S, E);
        if (BOTH(6)) GRID_BAR();
    }
    if (IN(7)) {
        pg8::Gemm g{F_HID, F_Wd_t, M, D, FF}; pg8::StaticOrder S; S.init(M, D, F.G, (int)blockIdx.x);
        pg8::EpiBf16<0> E{F_MIXF, D, nullptr, 0, 0, 1.f};
        pg8::gemm_phase<pg8::EpiBf16<0>, pg8::StaticOrder, PG8_ALIGN, PG8_SP2>(F.lds + RING_OFF, g, S, E);
        if (BOTH(7)) GRID_BAR();
    }
    if (IN(8)) { p8_post_ffn(F); }
#undef IN
#undef BOTH
}

#ifndef PHMASK
#define PHMASK 0x1ffu
#endif
template <unsigned MASK> static void launch_one(int grid, hipStream_t stream, Args a) { hipLaunchKernelGGL(hyb_fwd<MASK>, dim3(grid), dim3(NWAVES * 64), LDS_BYTES, stream, a); }
template <unsigned MASK> static bool prep_one(int* per_cu) {
    if (hipFuncSetAttribute((const void*)hyb_fwd<MASK>, hipFuncAttributeMaxDynamicSharedMemorySize, LDS_BYTES) != hipSuccess) return false;
    return hipOccupancyMaxActiveBlocksPerMultiprocessor(per_cu, (const void*)hyb_fwd<MASK>, NWAVES * 64, LDS_BYTES) == hipSuccess && *per_cu >= 1;
}
extern "C" void kernel_launch(void* const* d_in, const int* in_sizes, int n_in, void* d_out, int out_size, void* d_ws, size_t ws_size, hipStream_t stream) {
    static int grid = 0;
    if (grid == 0) {
        if (n_in != 24 || in_sizes[0] != M * D || out_size != M * D || ws_size < WS_END) { fprintf(stderr, "kernel_launch: unexpected shapes: n_in %d in0 %d out %d ws %zu\n", n_in, n_in > 0 ? in_sizes[0] : -1, out_size, ws_size); grid = -1; return; }
        int dev = 0, cus = 0, per_cu = 0; bool ok = true;
        if (hipGetDevice(&dev) != hipSuccess || hipDeviceGetAttribute(&cus, hipDeviceAttributeMultiprocessorCount, dev) != hipSuccess) { grid = -1; return; }
#if MK_N_LAUNCHES == 1
        ok = prep_one<PHMASK>(&per_cu);
#else
        ok = prep_one<0x001u>(&per_cu) && prep_one<0x002u>(&per_cu) && prep_one<0x20004u>(&per_cu) && prep_one<0x10004u>(&per_cu) && prep_one<0x008u>(&per_cu) && prep_one<0x010u>(&per_cu) && prep_one<0x020u>(&per_cu) && prep_one<0x040u>(&per_cu) && prep_one<0x080u>(&per_cu) && prep_one<0x100u>(&per_cu);
#endif
        if (!ok) { fprintf(stderr, "kernel_launch: LDS attribute / occupancy query failed (%d blocks per CU)\n", per_cu); (void)hipGetLastError(); grid = -1; return; }
        if (cus < 256) { fprintf(stderr, "kernel_launch: built for a 256-CU device, found %d CUs\n", cus); grid = -1; return; }
        grid = 256;
    }
    if (grid < 0) return;
    (void)hipMemsetAsync((char*)d_ws + WS_CTL, 0, CTL_ZERO_BYTES, stream);
    Args a{};
    for (int i = 0; i < 24; ++i) a.in[i] = (const float*)d_in[i];
    a.out = (float*)d_out; a.ws = (unsigned char*)d_ws;
#if MK_N_LAUNCHES == 1
    a.ph_lo = 0; a.ph_hi = NPH; a.li = 0; launch_one<PHMASK>(grid, stream, a);
#else
    a.ph_lo = 0; a.ph_hi = NPH;
    launch_one<0x001u>(grid, stream, a); launch_one<0x002u>(grid, stream, a); launch_one<0x20004u>(grid, stream, a); launch_one<0x10004u>(grid, stream, a); launch_one<0x008u>(grid, stream, a);
    launch_one<0x010u>(grid, stream, a); launch_one<0x020u>(grid, stream, a); launch_one<0x040u>(grid, stream, a); launch_one<0x080u>(grid, stream, a); launch_one<0x100u>(grid, stream, a);
#endif
}
```

```cpp
#include <hip/hip_runtime.h>
#include <cstdio>
#include <cstdint>
namespace pg8 {
#define PG8_LAS __attribute__((address_space(3)))
typedef unsigned short bf16_t;
typedef short bf16x8 __attribute__((ext_vector_type(8)));
typedef float f32x4 __attribute__((ext_vector_type(4)));
typedef unsigned u32x4 __attribute__((ext_vector_type(4)));
constexpr int BM = 256, BK = 64, HALF = 128, HTB = HALF * BK * 2  , STAGE_BYTES = 8 * HTB, NXCD = 8, WGM = 8;

__host__ __device__ __forceinline__ int lds_byte(int r, int c) { const int st = (r >> 4) * 2 + (c >> 5), rr = r & 15, cc = c & 31, ob = rr * 64 + cc * 2; return st * 1024 + (ob ^ (((ob >> 9) & 1) << 5)); }
__host__ __device__ __forceinline__ void stage_rc(int b, int& R, int& C) { const int st = b / 1024, sb = b % 1024, swz = sb ^ (((sb >> 9) & 1) << 5); R = (st >> 1) * 16 + swz / 64; C = (st & 1) * 32 + (swz % 64) / 2; }
__host__ __device__ __forceinline__ int perm32(int rho) { const int n = rho >> 4, i = rho & 15; return 8 * (i >> 2) + 4 * n + (i & 3); }

struct Unit { int pm, pn; };
struct Gemm { const bf16_t* A; const bf16_t* Bt; int M, N, K; };

struct StaticOrder {
    int nM, nN, nwg, G, c;
    __host__ __device__ void init(int M, int N, int G_, int c_) { nM = M / BM; nN = N / BM; nwg = nM * nN; G = G_; c = c_; }
    __host__ __device__ bool next(int i, Unit& u) const {
        const long L = (long)i * G + c; if (L >= nwg) return false;
        int wgid = (int)L; { const int q = nwg / NXCD, r = nwg % NXCD, xcd = wgid % NXCD, off = wgid / NXCD; wgid = (xcd < r ? xcd * (q + 1) : r * (q + 1) + (xcd - r) * q) + off; }
        const int nig = WGM * nN, gid = wgid / nig, fm = gid * WGM, gsz = (nM - fm) < WGM ? (nM - fm) : WGM;
        u.pm = fm + ((wgid % nig) % gsz); u.pn = (wgid % nig) / gsz; return true;
    }
    __device__ __forceinline__ void a_ready(const Unit&) const {}
    __device__ __forceinline__ void done(const Unit&) const {}
};

__device__ __forceinline__ unsigned cvt_pk_bf16(float lo, float hi) { unsigned r; asm volatile("v_cvt_pk_bf16_f32 %0, %1, %2" : "=v"(r) : "v"(lo), "v"(hi)); return r; }
typedef float f32x2 __attribute__((ext_vector_type(2)));
__device__ __forceinline__ f32x2 gelu_pk(f32x2 v) {
    const f32x2 av = __builtin_elementwise_abs(v), d = av * 0.2316418882f + 1.0f;
    f32x2 t; t.x = __builtin_amdgcn_rcpf(d.x); t.y = __builtin_amdgcn_rcpf(d.y);
    f32x2 q = t * 0.5307027145f + (-0.7265760135f); q = q * t + 0.7107068705f; q = q * t + (-0.142248368f); q = q * t + 0.127414796f; q = q * t;
    const f32x2 s = (v * v) * (-0.72134752044f);
    f32x2 e; e.x = __builtin_amdgcn_exp2f(s.x); e.y = __builtin_amdgcn_exp2f(s.y);
    const f32x2 m = v * (q * e), r = v - m;
    f32x2 o; o.x = v.x < 0.f ? m.x : r.x; o.y = v.y < 0.f ? m.y : r.y; return o;
}

template <int ACT  > struct EpiBf16 {
    static constexpr bool PERM = true, AFTER_DRAIN = false; static_assert(ACT == 0 || ACT == 1, "EpiBf16: ACT is 0 (none) or 1 (gelu_pk)");
    bf16_t* O; int ldc; const float* bias; int split_cols; size_t split_stride; float scale0;
    __device__ __forceinline__ void operator()(const f32x4 (&acc)[2][2][4][2], const Unit& u, int wr, int wc, int fr, int fq) const {
        const int row0 = u.pm * BM + wr * 64 + fr; int colt = u.pn * BM; bf16_t* base = O;
        float sc = 1.f; if (split_cols) { const int t = colt / split_cols; base += (size_t)t * split_stride; colt -= t * split_cols; if (t == 0) sc = scale0; }
        const int col0 = colt + wc * 32 + 8 * fq, bcol0 = u.pn * BM + wc * 32 + 8 * fq;
        f32x4 bv[2][2];
#pragma unroll
        for (int bj = 0; bj < 2; ++bj)
#pragma unroll
            for (int n = 0; n < 2; ++n) bv[bj][n] = bias ? *(const f32x4*)(bias + bcol0 + bj * HALF + 4 * n) : (f32x4){0.f, 0.f, 0.f, 0.f};
#pragma unroll
        for (int ai = 0; ai < 2; ++ai)
#pragma unroll
            for (int m = 0; m < 4; ++m) { bf16_t* rowp = base + (size_t)(row0 + ai * HALF + m * 16) * ldc + col0;
#pragma unroll
                for (int bj = 0; bj < 2; ++bj) { f32x4 v0 = acc[ai][bj][m][0] + bv[bj][0], v1 = acc[ai][bj][m][1] + bv[bj][1];
                    if (ACT == 1) { f32x2 a = gelu_pk((f32x2){v0[0], v0[1]}), b = gelu_pk((f32x2){v0[2], v0[3]}), c = gelu_pk((f32x2){v1[0], v1[1]}), d = gelu_pk((f32x2){v1[2], v1[3]});
                        v0 = (f32x4){a.x, a.y, b.x, b.y}; v1 = (f32x4){c.x, c.y, d.x, d.y}; }
                    v0 = v0 * sc; v1 = v1 * sc; u32x4 w; w.x = cvt_pk_bf16(v0[0], v0[1]); w.y = cvt_pk_bf16(v0[2], v0[3]); w.z = cvt_pk_bf16(v1[0], v1[1]); w.w = cvt_pk_bf16(v1[2], v1[3]);
                    *(u32x4*)(rowp + bj * HALF) = w; } }
    }
};
struct EpiSwiGLU {
    static constexpr bool PERM = true, AFTER_DRAIN = false;
    bf16_t* O; int ldc;
    __device__ __forceinline__ static float silu_mul(float g, float u) { return g * __builtin_amdgcn_rcpf(1.0f + __expf(-g)) * u; }
    __device__ __forceinline__ void operator()(const f32x4 (&acc)[2][2][4][2], const Unit& u, int wr, int wc, int fr, int fq) const {
        const int row0 = u.pm * BM + wr * 64 + fr; const int col0 = u.pn * HALF + wc * 32 + 8 * fq;
#pragma unroll
        for (int ai = 0; ai < 2; ++ai)
#pragma unroll
            for (int m = 0; m < 4; ++m) { bf16_t* rowp = O + (size_t)(row0 + ai * HALF + m * 16) * ldc + col0;
                const f32x4 g0 = acc[ai][0][m][0], g1 = acc[ai][0][m][1], u0 = acc[ai][1][m][0], u1 = acc[ai][1][m][1];
                u32x4 w; w.x = cvt_pk_bf16(silu_mul(g0[0], u0[0]), silu_mul(g0[1], u0[1])); w.y = cvt_pk_bf16(silu_mul(g0[2], u0[2]), silu_mul(g0[3], u0[3]));
                w.z = cvt_pk_bf16(silu_mul(g1[0], u1[0]), silu_mul(g1[1], u1[1])); w.w = cvt_pk_bf16(silu_mul(g1[2], u1[2]), silu_mul(g1[3], u1[3]));
                *(u32x4*)rowp = w; }
    }
};

template <class Epi, class Sched, bool ALIGN_EPI = false, bool SP2 = false>
__device__ __forceinline__ void gemm_phase(PG8_LAS unsigned char* lds, const Gemm g, const Sched& S, const Epi& E) {
    const int tid = threadIdx.x, wid = __builtin_amdgcn_readfirstlane(tid >> 6), lane = tid & 63, wr = wid >> 2, wc = wid & 3, fr = lane & 15, fq = lane >> 4;
    const int K = g.K, nt = K / BK;
    unsigned voffA[2], voffB[2];
#pragma unroll
    for (int i = 0; i < 2; ++i) { int R, C; stage_rc(tid * 16 + i * 8192, R, C); const int Rb = Epi::PERM ? ((R & ~31) + perm32(R & 31)) : R;
        voffA[i] = (unsigned)(R * K + C) * 2u; voffB[i] = (unsigned)(Rb * K + C) * 2u; }
    const size_t kstep = (size_t)(BK * 2);
    const size_t hstep = (size_t)HALF * K * 2;
    const size_t tstep = 2 * hstep;
    const unsigned ldsw = (unsigned)wid * 1024u;
    const int aoff = lds_byte(wr * 64 + fr, fq * 8), boff = lds_byte(wc * 32 + fr, fq * 8);
#define PG8_SA(b, h) (((b) * 2 + (h)) * HTB)
#define PG8_SB(b, h) ((4 + (b) * 2 + (h)) * HTB)
#define PG8_STAGE(bufoff, gbase, voff) do { _Pragma("unroll") for (int _i = 0; _i < 2; ++_i) \
        __builtin_amdgcn_global_load_lds((const unsigned*)((const char*)(gbase) + (voff)[_i]), (PG8_LAS unsigned*)(lds + (bufoff) + ldsw + _i * 8192), 16, 0, 0); } while (0)
#define PG8_LDA(dst, b, h) do { _Pragma("unroll") for (int m = 0; m < 4; ++m) _Pragma("unroll") for (int k = 0; k < 2; ++k) dst[m][k] = *(const PG8_LAS bf16x8*)(lds + PG8_SA(b, h) + aoff + m * 2048 + k * 1024); } while (0)
#define PG8_LDB(dst, b, h) do { _Pragma("unroll") for (int n = 0; n < 2; ++n) _Pragma("unroll") for (int k = 0; k < 2; ++k) dst[n][k] = *(const PG8_LAS bf16x8*)(lds + PG8_SB(b, h) + boff + n * 2048 + k * 1024); } while (0)
#define PG8_MMA(ai, bj, At, Bt) do { __builtin_amdgcn_s_setprio(1); _Pragma("unroll") for (int m = 0; m < 4; ++m) _Pragma("unroll") for (int n = 0; n < 2; ++n) _Pragma("unroll") for (int k = 0; k < 2; ++k) \
        acc[ai][bj][m][n] = __builtin_amdgcn_mfma_f32_16x16x32_bf16(Bt[n][k], At[m][k], acc[ai][bj][m][n], 0, 0, 0); __builtin_amdgcn_s_setprio(0); } while (0)
#define PG8_WAIT_V(n) asm volatile("s_waitcnt vmcnt(" #n ")" ::: "memory")
#define PG8_WAIT_L(n) asm volatile("s_waitcnt lgkmcnt(" #n ")" ::: "memory")
#define PG8_BAR __builtin_amdgcn_s_barrier()
#define PG8_SCHED __builtin_amdgcn_sched_barrier(0)
    Unit cur, nxt; int ui = 0;
    if (!S.next(0, cur)) return;
    f32x4 acc[2][2][4][2];
#pragma unroll
    for (int a = 0; a < 2; ++a)
#pragma unroll
        for (int b = 0; b < 2; ++b)
#pragma unroll
            for (int m = 0; m < 4; ++m)
#pragma unroll
                for (int n = 0; n < 2; ++n) acc[a][b][m][n] = (f32x4){0.f, 0.f, 0.f, 0.f};
    bf16x8 At[4][2], B0[2][2], B1[2][2];
    const char* cA = (const char*)g.A + (size_t)cur.pm * tstep; const char* cB = (const char*)g.Bt + (size_t)cur.pn * tstep;
    S.a_ready(cur);
    if constexpr (SP2) {
        PG8_STAGE(PG8_SB(0, 0), cB, voffB); PG8_STAGE(PG8_SB(0, 1), cB + hstep, voffB); PG8_STAGE(PG8_SA(0, 0), cA, voffA); PG8_STAGE(PG8_SA(0, 1), cA + hstep, voffA);
        if (wr == 1) PG8_BAR;
        PG8_WAIT_V(2); PG8_BAR;
        PG8_STAGE(PG8_SB(1, 0), cB + kstep, voffB); PG8_STAGE(PG8_SA(1, 0), cA + kstep, voffA); PG8_STAGE(PG8_SB(1, 1), cB + hstep + kstep, voffB);
        PG8_WAIT_V(6); PG8_BAR;
    } else {
        PG8_STAGE(PG8_SB(0, 0), cB, voffB); PG8_STAGE(PG8_SA(0, 0), cA, voffA); PG8_STAGE(PG8_SB(0, 1), cB + hstep, voffB); PG8_STAGE(PG8_SA(0, 1), cA + hstep, voffA);
        if (wr == 1) PG8_BAR;
        PG8_WAIT_V(4); PG8_BAR;
        PG8_STAGE(PG8_SB(1, 0), cB + kstep, voffB); PG8_STAGE(PG8_SA(1, 0), cA + kstep, voffA); PG8_STAGE(PG8_SB(1, 1), cB + hstep + kstep, voffB);
        PG8_WAIT_V(6); PG8_BAR;
    }
    for (;;) {
        const bool has_next = S.next(ui + 1, nxt);
        const char* nA = has_next ? (const char*)g.A + (size_t)nxt.pm * tstep : cA; const char* nB = has_next ? (const char*)g.Bt + (size_t)nxt.pn * tstep : cB;
        for (int t = 0; t < nt; t += 2) {
            const bool last = (t == nt - 2);
            const char* a1 = cA + (size_t)(t + 1) * kstep;
            const char* a2 = last ? nA : cA + (size_t)(t + 2) * kstep; const char* b2 = last ? nB : cB + (size_t)(t + 2) * kstep;
            const char* a3 = a2 + kstep; const char* b3 = b2 + kstep;
            if (last && has_next) S.a_ready(nxt);
            if constexpr (SP2) {
            PG8_LDB(B0, 0, 0); PG8_LDB(B1, 0, 1); PG8_SCHED; PG8_LDA(At, 0, 0); PG8_STAGE(PG8_SA(1, 1), a1 + hstep, voffA);
            PG8_WAIT_V(8); PG8_WAIT_L(0); PG8_BAR; PG8_MMA(0, 0, At, B0); PG8_MMA(0, 1, At, B1); PG8_BAR; PG8_SCHED;
            PG8_LDA(At, 0, 1); PG8_STAGE(PG8_SB(0, 0), b2, voffB); PG8_STAGE(PG8_SB(0, 1), b2 + hstep, voffB); PG8_STAGE(PG8_SA(0, 0), a2, voffA);
            PG8_WAIT_V(8); PG8_WAIT_L(0); PG8_BAR; PG8_MMA(1, 0, At, B0); PG8_MMA(1, 1, At, B1); PG8_BAR; PG8_SCHED;
            PG8_LDB(B0, 1, 0); PG8_LDB(B1, 1, 1); PG8_SCHED; PG8_LDA(At, 1, 0); PG8_STAGE(PG8_SA(0, 1), a2 + hstep, voffA);
            PG8_WAIT_V(8); PG8_WAIT_L(0); PG8_BAR; PG8_MMA(0, 0, At, B0); PG8_MMA(0, 1, At, B1); PG8_BAR; PG8_SCHED;
            PG8_LDA(At, 1, 1); PG8_STAGE(PG8_SB(1, 0), b3, voffB); PG8_STAGE(PG8_SB(1, 1), b3 + hstep, voffB); PG8_STAGE(PG8_SA(1, 0), a3, voffA);
            PG8_WAIT_V(8); PG8_WAIT_L(0); PG8_BAR; PG8_MMA(1, 0, At, B0); PG8_MMA(1, 1, At, B1); PG8_BAR; PG8_SCHED;
            } else {
            PG8_LDB(B0, 0, 0); PG8_SCHED; PG8_LDA(At, 0, 0); PG8_STAGE(PG8_SA(1, 1), a1 + hstep, voffA);
            PG8_WAIT_L(8); PG8_BAR; PG8_WAIT_L(0); PG8_MMA(0, 0, At, B0); PG8_BAR; PG8_SCHED;
            PG8_LDB(B1, 0, 1); PG8_STAGE(PG8_SB(0, 0), b2, voffB);
            PG8_BAR; PG8_WAIT_L(0); PG8_MMA(0, 1, At, B1); PG8_BAR;
            PG8_LDA(At, 0, 1); PG8_STAGE(PG8_SA(0, 0), a2, voffA);
            PG8_BAR; PG8_WAIT_L(0); PG8_MMA(1, 0, At, B0); PG8_BAR; PG8_SCHED;
            PG8_STAGE(PG8_SB(0, 1), b2 + hstep, voffB);
            PG8_WAIT_V(6); PG8_BAR; PG8_MMA(1, 1, At, B1); PG8_BAR;
            PG8_LDB(B0, 1, 0); PG8_SCHED; PG8_LDA(At, 1, 0); PG8_STAGE(PG8_SA(0, 1), a2 + hstep, voffA);
            PG8_WAIT_L(8); PG8_BAR; PG8_WAIT_L(0); PG8_MMA(0, 0, At, B0); PG8_BAR; PG8_SCHED;
            PG8_LDB(B1, 1, 1); PG8_STAGE(PG8_SB(1, 0), b3, voffB);
            PG8_BAR; PG8_WAIT_L(0); PG8_MMA(0, 1, At, B1); PG8_BAR;
            PG8_LDA(At, 1, 1); PG8_STAGE(PG8_SA(1, 0), a3, voffA);
            PG8_BAR; PG8_WAIT_L(0); PG8_MMA(1, 0, At, B0); PG8_BAR; PG8_SCHED;
            PG8_STAGE(PG8_SB(1, 1), b3 + hstep, voffB);
            PG8_WAIT_V(6); PG8_BAR; PG8_MMA(1, 1, At, B1); PG8_BAR;
            }
        }
        if constexpr (ALIGN_EPI) { if (wr == 0) PG8_BAR; }
        if constexpr (!Epi::AFTER_DRAIN) { E(acc, cur, wr, wc, fr, fq); S.done(cur); }
        if (!has_next) break;
#pragma unroll
        for (int a = 0; a < 2; ++a)
#pragma unroll
            for (int b = 0; b < 2; ++b)
#pragma unroll
                for (int m = 0; m < 4; ++m)
#pragma unroll
                    for (int n = 0; n < 2; ++n) acc[a][b][m][n] = (f32x4){0.f, 0.f, 0.f, 0.f};
        cur = nxt; cA = nA; cB = nB; ++ui;
        if constexpr (ALIGN_EPI) { if (wr == 1) PG8_BAR; }
    }
    PG8_WAIT_V(0);
    if constexpr (!ALIGN_EPI) { if (wr == 0) PG8_BAR; }
    PG8_BAR;
    if constexpr (Epi::AFTER_DRAIN) { E.fused(acc, cur, wr, wc, fr, fq, lds, wid, lane); S.done(cur); }
#undef PG8_SA
#undef PG8_SB
#undef PG8_STAGE
#undef PG8_LDA
#undef PG8_LDB
#undef PG8_MMA
#undef PG8_WAIT_V
#undef PG8_WAIT_L
#undef PG8_BAR
#undef PG8_SCHED
}
}

#ifndef PG8_SP2
#define PG8_SP2 true
#endif
#ifndef PG8_ALIGN
#define PG8_ALIGN true
#endif
constexpr int NWAVES = 8;
constexpr int NPH = 9;
#ifndef MK_N_LAUNCHES
#define MK_N_LAUNCHES 1
#endif
constexpr int N_LAUNCHES = MK_N_LAUNCHES;
static_assert(N_LAUNCHES == 1 || N_LAUNCHES == NPH, "MK_N_LAUNCHES is 1 (one launch) or 9 (test build: one launch per phase)");

constexpr int BATCH = 8, T = 8192, D = 1024, M = BATCH * T;
constexpr int INC = 4624, NIN = 4608;
constexpr int FF = 2816, NGU = 2 * FF, MIXW = 2048, XBC = 1536;
constexpr int PC_LX = 0, PC_LG = 1024, PC_Z = 2048, PC_X = 3072, PC_B = 4096, PC_C = 4352;
constexpr float EPS = 1e-6f;

constexpr size_t MiB = 1u << 20;
constexpr size_t WS_CTL = 0, CTL_ZERO_BYTES = 1 * MiB;
constexpr size_t WS_WIN = 2 * MiB, WS_WOUT = 11 * MiB, WS_WGU = 15 * MiB, WS_WD = 26 * MiB;
constexpr size_t WS_DTV = 32 * MiB;
constexpr size_t WS_PART = 36 * MiB;
constexpr size_t WS_PROJ = 64 * MiB;
constexpr size_t WS_XN = 640 * MiB;
constexpr size_t WS_IMG = 640 * MiB;
constexpr size_t WS_YMIX = 768 * MiB;
constexpr size_t WS_HID = 64 * MiB;
constexpr size_t WS_MIXF = 416 * MiB;
constexpr size_t WS_END = 1024 * MiB;
static_assert(WS_WIN + (size_t)NIN * D * 2 <= WS_WOUT && WS_WOUT + (size_t)D * MIXW * 2 <= WS_WGU && WS_WGU + (size_t)NGU * D * 2 <= WS_WD && WS_WD + (size_t)D * FF * 2 <= WS_DTV, "weights map");
static_assert(WS_DTV + (size_t)M * 16 * 4 <= WS_PART && WS_PART + (size_t)M * 32 * 4 <= WS_PROJ && WS_PROJ + (size_t)M * NIN * 2 <= WS_XN && WS_XN + (size_t)M * D * 2 <= WS_YMIX && WS_YMIX + (size_t)M * MIXW * 2 <= WS_END, "d_ws map");
static_assert(WS_HID + (size_t)M * FF * 2 <= WS_MIXF && WS_MIXF + (size_t)M * D * 2 <= WS_XN, "overlay map");
constexpr int CW_TMO = 0, CW_CODE = 1;
constexpr int CW_BAR = 4096;

constexpr int RING_OFF = 0, RING_BYTES = 131072;
constexpr int LDS_BYTES = 163840;
constexpr int LDSCTL_OFF = LDS_BYTES - 512, MISC_OFF = LDSCTL_OFF + 320;
static_assert(MISC_OFF + 128 <= LDS_BYTES, "LDS map");
#define GAS __attribute__((address_space(1)))
#define LAS __attribute__((address_space(3)))
typedef unsigned short bf16;
typedef unsigned v4u __attribute__((ext_vector_type(4)));
typedef float f32x4 __attribute__((ext_vector_type(4)));
typedef short bf16x8 __attribute__((ext_vector_type(8)));
typedef GAS unsigned gu32;
typedef GAS unsigned long long gu64;
#define RLX_AGENT __ATOMIC_RELAXED, __HIP_MEMORY_SCOPE_AGENT
#define LDS_WAIT() asm volatile("s_waitcnt lgkmcnt(0)" ::: "memory")
#define VM_WAIT() asm volatile("s_waitcnt vmcnt(0)" ::: "memory")
__device__ __forceinline__ unsigned long long rt() { return __builtin_amdgcn_s_memrealtime(); }
__device__ __forceinline__ unsigned f2bf(float f) { unsigned u = __builtin_bit_cast(unsigned, f); return (u + 0x7fffu + ((u >> 16) & 1u)) >> 16; }
__device__ __forceinline__ unsigned pk2(float lo, float hi) { return f2bf(lo) | (f2bf(hi) << 16); }

#define XB_TMO      128
#define XB_XCNT(j)  (256  + 64 * (j))
#define XB_XSUB(j)  (1280 + 64 * (j))
#define XB_XGEN(j)  (2304 + 64 * (j))
#define XB_TOP      3328
#define XB_TOPGEN   3392
#define XCD_BAR_WORDS 3456
#define XB_SPIN_CAP (1u << 18)

__device__ __forceinline__ unsigned xb_ld(unsigned* p)              { return __hip_atomic_load(p, __ATOMIC_RELAXED, __HIP_MEMORY_SCOPE_AGENT); }
__device__ __forceinline__ unsigned xb_add(unsigned* p, unsigned v) { return __hip_atomic_fetch_add(p, v, __ATOMIC_RELAXED, __HIP_MEMORY_SCOPE_AGENT); }
__device__ __forceinline__ unsigned xb_xcc_id() { return (unsigned)__builtin_amdgcn_s_getreg((3 << 11) | 20) & 0xFu; }
#define XB_SPIN(cond, bar) do { unsigned _sp = 0; while (cond) { __builtin_amdgcn_s_sleep(1); \
    if ((++_sp & 255u) == 0u) { if (xb_ld(&(bar)[XB_TMO])) break; if (_sp > XB_SPIN_CAP) { atomicAdd(&(bar)[XB_TMO], 1u); break; } } } } while (0)

struct XcdBarrier {
    unsigned* bar; unsigned x;
    volatile LAS unsigned* st;
};

__device__ __forceinline__ XcdBarrier xcd_barrier_post(unsigned* bar, volatile LAS unsigned* st) {
    XcdBarrier b; b.bar = bar; b.x = xb_xcc_id(); b.st = st;
    if (threadIdx.x == 0) (void)xb_add(&bar[XB_XCNT(b.x)], 1u);
    return b;
}
__device__ __forceinline__ void xcd_barrier_complete(unsigned* bar, unsigned x, unsigned& nloc, unsigned& nx) {
    const unsigned G = gridDim.x * gridDim.y * gridDim.z;
    unsigned sum, cnt, mine, sp = 0u;
    for (;;) {
        sum = 0u; cnt = 0u; mine = 0u;
#pragma unroll
        for (unsigned j = 0; j < 16; ++j) { const unsigned c = xb_ld(&bar[XB_XCNT(j)]); sum += c; cnt += (c > 0u) ? 1u : 0u; mine = (j == x) ? c : mine; }
        if (sum == G) break;
        __builtin_amdgcn_s_sleep(1);
        if ((++sp & 255u) == 0u) { if (xb_ld(&bar[XB_TMO])) break; if (sp > XB_SPIN_CAP) { atomicAdd(&bar[XB_TMO], 1u); break; } }
    }
    nloc = mine > 0u ? mine : 1u; nx = cnt > 0u ? cnt : 1u;
}

__device__ __forceinline__ void xcd_barrier(const XcdBarrier& b) {
    asm volatile("s_waitcnt vmcnt(0)" ::: "memory");
    __syncthreads();
    if (threadIdx.x == 0) {
        unsigned* bar = b.bar;
        __builtin_amdgcn_s_waitcnt(0);
        unsigned nloc = b.st[0], nx = b.st[1];
        if (nloc == 0u) { xcd_barrier_complete(bar, b.x, nloc, nx); b.st[0] = nloc; b.st[1] = nx; }
        const unsigned old = xb_add(&bar[XB_XSUB(b.x)], 1u);
        const unsigned gen = old / nloc;
        if (old + 1u == (gen + 1u) * nloc) {
            __builtin_amdgcn_fence(__ATOMIC_RELEASE, "agent");
            asm volatile("s_waitcnt vmcnt(0)" ::: "memory");
            const unsigned og = xb_add(&bar[XB_TOP], 1u);
            const unsigned tg = og / nx;
            if (og + 1u == (tg + 1u) * nx) xb_add(&bar[XB_TOPGEN], 1u);
            else XB_SPIN(xb_ld(&bar[XB_TOPGEN]) == tg, bar);
            __builtin_amdgcn_fence(__ATOMIC_ACQUIRE, "agent");
            xb_add(&bar[XB_XGEN(b.x)], 1u);
            asm volatile("s_waitcnt vmcnt(0)" ::: "memory");
        } else {
            XB_SPIN(xb_ld(&bar[XB_XGEN(b.x)]) == gen, bar);
            __builtin_amdgcn_fence(__ATOMIC_ACQUIRE, "agent");
            asm volatile("s_waitcnt vmcnt(0)" ::: "memory");
        }
    }
    __syncthreads();
}

struct Frame {
    LAS unsigned char* lds;
    volatile LAS unsigned* MISC;
    gu32* ctl;
    int tid, lane, wave;
    int vcu, G;
    const float* const* in; float* out; unsigned char* ws;
};
#define F_x        (F.in[0])
#define F_g_pre    (F.in[1])
#define F_w_in     (F.in[2])
#define F_lru_cw   (F.in[3])
#define F_lru_cb   (F.in[4])
#define F_lru_wa   (F.in[5])
#define F_lru_ba   (F.in[6])
#define F_lru_wx   (F.in[7])
#define F_lru_bx   (F.in[8])
#define F_lru_lam  (F.in[9])
#define F_g_lru    (F.in[10])
#define F_ssd_cw   (F.in[11])
#define F_ssd_cb   (F.in[12])
#define F_ssd_dtb  (F.in[13])
#define F_ssd_alog (F.in[14])
#define F_ssd_d    (F.in[15])
#define F_g_ssd    (F.in[16])
#define F_w_out    (F.in[17])
#define F_g_pm     (F.in[18])
#define F_g_pf     (F.in[19])
#define F_w_gate   (F.in[20])
#define F_w_up     (F.in[21])
#define F_w_down   (F.in[22])
#define F_g_post   (F.in[23])
#define F_Win_t  ((bf16*)(F.ws + WS_WIN))
#define F_Wout_t ((bf16*)(F.ws + WS_WOUT))
#define F_Wgu_t  ((bf16*)(F.ws + WS_WGU))
#define F_Wd_t   ((bf16*)(F.ws + WS_WD))
#define F_PROJ   ((bf16*)(F.ws + WS_PROJ))
#define F_XN     ((bf16*)(F.ws + WS_XN))
#define F_YMIX   ((bf16*)(F.ws + WS_YMIX))
#define F_HID    ((bf16*)(F.ws + WS_HID))
#define F_MIXF   ((bf16*)(F.ws + WS_MIXF))
#define F_DTV    ((float*)(F.ws + WS_DTV))
#define F_PART   ((float*)(F.ws + WS_PART))

__device__ __forceinline__ float wave_sum(float v) {
#pragma unroll
    for (int o = 1; o < 64; o <<= 1) v += __shfl_xor(v, o);
    return v;
}
__device__ __forceinline__ float bf2f(bf16 h) { return __builtin_bit_cast(float, (unsigned)h << 16); }
__device__ __forceinline__ float bflo(unsigned w) { return __builtin_bit_cast(float, w << 16); }
__device__ __forceinline__ float bfhi(unsigned w) { return __builtin_bit_cast(float, w & 0xffff0000u); }
__device__ __forceinline__ float sigmoidf_(float v) { return 1.0f / (1.0f + expf(-v)); }
__device__ __forceinline__ float siluf_(float v) { return v / (1.0f + expf(-v)); }
__device__ __forceinline__ float softplusf_(float v) { return fmaxf(v, 0.f) + log1pf(expf(-fabsf(v))); }
__device__ __forceinline__ float gelu_tanhf_(float v) { const float c = 0.7978845608028654f; return 0.5f * v * (1.0f + tanhf(c * (v + 0.044715f * v * v * v))); }

__device__ __forceinline__ void p0_transpose_item(const float* W, int ldw, int Kdst, int k0, int n0, bf16* WT, int drow0, LAS float* scr, int lane) {
#pragma unroll 8
    for (int i = 0; i < 32; ++i) { const int kk = 2 * i + (lane >> 5); scr[kk * 33 + (lane & 31)] = W[(size_t)(k0 + kk) * ldw + n0 + (lane & 31)]; }
    LDS_WAIT(); asm volatile("" ::: "memory");
    const int c = lane & 7;
#pragma unroll
    for (int j = 0; j < 4; ++j) { const int n = (lane >> 3) + 8 * j; const LAS float* s = scr + (8 * c) * 33 + n;
        v4u o; o.x = pk2(s[0 * 33], s[1 * 33]); o.y = pk2(s[2 * 33], s[3 * 33]); o.z = pk2(s[4 * 33], s[5 * 33]); o.w = pk2(s[6 * 33], s[7 * 33]);
        *(GAS v4u*)(WT + (size_t)(drow0 + n) * Kdst + k0 + 8 * c) = o; }
    LDS_WAIT(); asm volatile("" ::: "memory");
}
__device__ __forceinline__ void p0_prologue(Frame& F) {
    LAS float* scr = (LAS float*)(F.lds + RING_OFF + F.wave * 16384);
    const int gw = F.vcu * NWAVES + F.wave, NGW = F.G * NWAVES;
    constexpr int I_IN = (D / 64) * (NIN / 32), I_OUT = (MIXW / 64) * (D / 32), I_G = (D / 64) * (FF / 32), I_D = (FF / 64) * (D / 32);
    constexpr int NITEMS = I_IN + I_OUT + 2 * I_G + I_D;
    for (int it = gw; it < NITEMS; it += NGW) {
        int r = it;
        if (r < I_IN) { const int nb = r % (NIN / 32), kb = r / (NIN / 32); p0_transpose_item(F_w_in, INC, D, 64 * kb, 32 * nb, F_Win_t, 32 * nb, scr, F.lane); continue; } r -= I_IN;
        if (r < I_OUT) { const int nb = r % (D / 32), kb = r / (D / 32); p0_transpose_item(F_w_out, D, MIXW, 64 * kb, 32 * nb, F_Wout_t, 32 * nb, scr, F.lane); continue; } r -= I_OUT;
        if (r < I_G) { const int nb = r % (FF / 32), kb = r / (FF / 32), n0 = 32 * nb; p0_transpose_item(F_w_gate, FF, D, 64 * kb, n0, F_Wgu_t, 256 * (n0 >> 7) + (n0 & 127), scr, F.lane); continue; } r -= I_G;
        if (r < I_G) { const int nb = r % (FF / 32), kb = r / (FF / 32), n0 = 32 * nb; p0_transpose_item(F_w_up, FF, D, 64 * kb, n0, F_Wgu_t, 256 * (n0 >> 7) + 128 + (n0 & 127), scr, F.lane); continue; } r -= I_G;
        { const int nb = r % (D / 32), kb = r / (D / 32); p0_transpose_item(F_w_down, D, FF, 64 * kb, 32 * nb, F_Wd_t, 32 * nb, scr, F.lane); }
    }
    __syncthreads();
    LAS f32x4* tbl = (LAS f32x4*)(F.lds + RING_OFF);
    for (int e = F.tid; e < 4096; e += NWAVES * 64) { const int l = e & 63, hq = (e >> 6) & 3, ci = e >> 8; const int col = 4 * l + 256 * (ci >> 2) + (ci & 3);
        const float* src = F_w_in + (size_t)col * INC + NIN + hq * 4; tbl[e] = (f32x4){src[0], src[1], src[2], src[3]}; }
    __syncthreads();
    f32x4 g[4];
#pragma unroll
    for (int j = 0; j < 4; ++j) g[j] = *(const f32x4*)(F_g_pre + 4 * F.lane + 256 * j);
    const float dtb = F_ssd_dtb[F.lane & 15];
    for (int r0 = gw * 4; r0 < M; r0 += NGW * 4) {
        f32x4 xv[4][4];
#pragma unroll
        for (int rr = 0; rr < 4; ++rr) {
            const float* xr = F_x + (size_t)(r0 + rr) * D + 4 * F.lane; float ss = 0.f;
#pragma unroll
            for (int j = 0; j < 4; ++j) { xv[rr][j] = *(const f32x4*)(xr + 256 * j); ss += (xv[rr][j].x * xv[rr][j].x + xv[rr][j].y * xv[rr][j].y) + (xv[rr][j].z * xv[rr][j].z + xv[rr][j].w * xv[rr][j].w); }
            const float rstd = 1.0f / sqrtf(wave_sum(ss) * (1.0f / D) + EPS);
            GAS unsigned long long* o8 = (GAS unsigned long long*)(F_XN + (size_t)(r0 + rr) * D) + F.lane;
#pragma unroll
            for (int j = 0; j < 4; ++j) { xv[rr][j] = xv[rr][j] * rstd * g[j];
                o8[64 * j] = (unsigned long long)pk2(xv[rr][j].x, xv[rr][j].y) | ((unsigned long long)pk2(xv[rr][j].z, xv[rr][j].w) << 32); }
        }
        float v[64];
#pragma unroll
        for (int i = 0; i < 64; ++i) v[i] = 0.f;
#pragma unroll
        for (int j = 0; j < 4; ++j)
#pragma unroll
            for (int e = 0; e < 4; ++e)
#pragma unroll
                for (int hq = 0; hq < 4; ++hq) { const f32x4 w = tbl[((j * 4 + e) * 4 + hq) * 64 + F.lane];
#pragma unroll
                    for (int rr = 0; rr < 4; ++rr) { const float xe = xv[rr][j][e];
                        v[rr * 16 + hq * 4 + 0] += xe * w.x; v[rr * 16 + hq * 4 + 1] += xe * w.y; v[rr * 16 + hq * 4 + 2] += xe * w.z; v[rr * 16 + hq * 4 + 3] += xe * w.w; }
                    if (hq == 3) asm volatile("" ::: "memory"); }
#pragma unroll
        for (int half = 32; half >= 1; half >>= 1) { const bool up = (F.lane & half) != 0;
#pragma unroll
            for (int i = 0; i < half; ++i) { const float send = up ? v[i] : v[i + half]; const float keep = up ? v[i + half] : v[i]; v[i] = keep + __shfl_xor(send, half); } }
        F_DTV[(size_t)(r0 + (F.lane >> 4)) * 16 + (F.lane & 15)] = softplusf_(v[0] + dtb);
    }
}

__device__ __forceinline__ void lru_baseline_unit(Frame& F, int unit) {
    const int b = unit >> 4, blk = unit & 15, lane = F.lane, ch = blk * 64 + lane;
    LAS float* wl = (LAS float*)(F.lds + RING_OFF);
#pragma unroll 8
    for (int i = 0; i < 64; ++i) { wl[i * 64 + lane] = F_lru_wa[blk * 4096 + i * 64 + lane]; wl[4096 + i * 64 + lane] = F_lru_wx[blk * 4096 + i * 64 + lane]; }
    LDS_WAIT(); asm volatile("" ::: "memory");
    const float ba = F_lru_ba[ch], bx = F_lru_bx[ch], sp = softplusf_(-F_lru_lam[ch]);
    const float c0 = F_lru_cw[ch], c1 = F_lru_cw[1024 + ch], c2 = F_lru_cw[2048 + ch], c3 = F_lru_cw[3072 + ch], cb = F_lru_cb[ch];
    float xm3 = 0.f, xm2 = 0.f, xm1 = 0.f, h = 0.f;
    const bf16* px = F_PROJ + (size_t)(b * T) * NIN + PC_LX + ch; const bf16* pg = F_PROJ + (size_t)(b * T) * NIN + PC_LG + ch;
    for (int t0 = 0; t0 < T; t0 += 8) {
        float xr[8], gr[8];
#pragma unroll
        for (int j = 0; j < 8; ++j) { xr[j] = bf2f(px[(size_t)(t0 + j) * NIN]); gr[j] = bf2f(pg[(size_t)(t0 + j) * NIN]); }
#pragma unroll
        for (int j = 0; j < 8; ++j) {
            const float x0 = xr[j]; const float lx = cb + c0 * xm3 + c1 * xm2 + c2 * xm1 + c3 * x0; xm3 = xm2; xm2 = xm1; xm1 = x0;
            float rp = ba, ip = bx;
#pragma unroll
            for (int i = 0; i < 64; ++i) { const float s = __builtin_bit_cast(float, __builtin_amdgcn_readlane(__builtin_bit_cast(int, lx), i)); rp = fmaf(s, wl[i * 64 + lane], rp); ip = fmaf(s, wl[4096 + i * 64 + lane], ip); }
            const float r = sigmoidf_(rp), ig = sigmoidf_(ip), la = -8.0f * r * sp, a = expf(la), mult = sqrtf(-expm1f(2.0f * la));
            h = a * h + mult * (ig * lx);
            const float y = h * gelu_tanhf_(gr[j]);
            const float ss = wave_sum(y * y);
            const size_t row = (size_t)(b * T + t0 + j);
            F_YMIX[row * MIXW + ch] = (bf16)f2bf(y);
            if (lane == 0) F_PART[row * 32 + blk] = ss;
        }
    }
}
__device__ __forceinline__ float ssd_convsilu(Frame& F, int b, int t, int c) {
    float acc = F_ssd_cb[c];
#pragma unroll
    for (int k = 0; k < 4; ++k) { const int tk = t - 3 + k; if (tk >= 0) acc += F_ssd_cw[k * XBC + c] * bf2f(F_PROJ[(size_t)(b * T + tk) * NIN + PC_X + c]); }
    return siluf_(acc);
}
__device__ __forceinline__ void ssd_baseline_unit(Frame& F, int unit) {
    const int b = unit >> 4, h = unit & 15, g = h >> 3, tid = F.tid, p = tid >> 3, nq = tid & 7;
    LAS float* Bs = (LAS float*)(F.lds + RING_OFF);
    LAS float* Cs = Bs + 32 * 128;
    LAS float* xs = Cs + 32 * 128;
    LAS float* zs = xs + 32 * 64;
    LAS float* yb = zs + 32 * 64;
    LAS float* dts = yb + 32 * 64;
    const float A = -expf(F_ssd_alog[h]), Dh = F_ssd_d[h];
    float S[16];
#pragma unroll
    for (int i = 0; i < 16; ++i) S[i] = 0.f;
    for (int t0 = 0; t0 < T; t0 += 32) {
        for (int e = tid; e < 32 * 128; e += NWAVES * 64) { const int tt = e >> 7, n = e & 127;
            Bs[e] = ssd_convsilu(F, b, t0 + tt, 1024 + g * 128 + n); Cs[e] = ssd_convsilu(F, b, t0 + tt, 1280 + g * 128 + n); }
        for (int e = tid; e < 32 * 64; e += NWAVES * 64) { const int tt = e >> 6, pp = e & 63;
            xs[e] = ssd_convsilu(F, b, t0 + tt, h * 64 + pp); zs[e] = bf2f(F_PROJ[(size_t)(b * T + t0 + tt) * NIN + PC_Z + h * 64 + pp]); }
        if (tid < 32) dts[tid] = F_DTV[(size_t)(b * T + t0 + tid) * 16 + h];
        __syncthreads();
        for (int tt = 0; tt < 32; ++tt) {
            const float dtv = dts[tt], da = expf(dtv * A), xv = xs[tt * 64 + p], dtx = dtv * xv; float yp = 0.f;
#pragma unroll
            for (int i = 0; i < 16; ++i) { const float Bv = Bs[tt * 128 + nq * 16 + i], Cv = Cs[tt * 128 + nq * 16 + i]; S[i] = S[i] * da + dtx * Bv; yp += Cv * S[i]; }
            yp += __shfl_xor(yp, 1); yp += __shfl_xor(yp, 2); yp += __shfl_xor(yp, 4);
            if (nq == 0) { const float z = zs[tt * 64 + p]; yb[tt * 64 + p] = (yp + Dh * xv) * siluf_(z); }
        }
        __syncthreads();
        for (int e = tid; e < 32 * 64; e += NWAVES * 64) { const int tt = e >> 6, pp = e & 63; F_YMIX[(size_t)(b * T + t0 + tt) * MIXW + 1024 + h * 64 + pp] = (bf16)f2bf(yb[e]); }
#pragma unroll
        for (int r = 0; r < 4; ++r) { const int tt = 4 * F.wave + r; const float v = yb[tt * 64 + F.lane]; const float ss = wave_sum(v * v);
            if (F.lane == 0) F_PART[(size_t)(b * T + t0 + tt) * 32 + 16 + h] = ss; }
        __syncthreads();
    }
}
#ifndef USE_SSD_OPT
#define USE_SSD_OPT 1
#endif
#ifndef USE_LRU_OPT
#define USE_LRU_OPT 1
#endif

typedef float f32x16 __attribute__((ext_vector_type(16)));
typedef unsigned v2u __attribute__((ext_vector_type(2)));
constexpr int TS_CC = 0, TS_BC = 32768, TS_BCT = 65536, TS_SXT = 98304, TS_XSDT = 114688, TS_S = 131072, TS_CW = 147456, TS_ARR = 153856;
static_assert(TS_ARR + 2 * 2048 <= LDSCTL_OFF && TS_CC == 0 && TS_BC == 32768 && TS_BCT == 65536, "SSD LDS map (the tile images are LDS bytes [0, 96 KiB))");
__device__ __forceinline__ int skey(int row) { return (row ^ (row >> 3)) & 15; }
__device__ __forceinline__ int sswz(int row, int byte) { return row * 256 + (byte ^ (skey(row) << 4)); }
#define MFMA32(a, b, c) __builtin_amdgcn_mfma_f32_32x32x16_bf16((a), (b), (c), 0, 0, 0)
__device__ __forceinline__ float fsilu(float v) { return v * __builtin_amdgcn_rcpf(1.0f + __expf(-v)); }
__device__ __forceinline__ float bfsel(const v4u& v, int e) { const unsigned d = v[e >> 1]; return (e & 1) ? bfhi(d) : bflo(d); }
#define SSD_CONV_PAIR(NT, raw, cw, chn, d, ol, oh) do { \
        const f32x2 w0_ = *(const LAS f32x2*)((cw) + 2 * (d)), w1_ = *(const LAS f32x2*)((cw) + (chn) + 2 * (d)), w2_ = *(const LAS f32x2*)((cw) + 2 * (chn) + 2 * (d)), w3_ = *(const LAS f32x2*)((cw) + 3 * (chn) + 2 * (d)), wb_ = *(const LAS f32x2*)((cw) + 4 * (chn) + 2 * (d)); \
        float lo_[(NT) + 3], hi_[(NT) + 3]; \
        _Pragma("unroll") for (int i_ = 0; i_ < (NT) + 3; ++i_) { lo_[i_] = bflo((raw)[i_][d]); hi_[i_] = bfhi((raw)[i_][d]); } \
        _Pragma("unroll") for (int j_ = 0; j_ < (NT); ++j_) { \
            ol[j_] = fsilu(wb_.x + w0_.x * lo_[j_] + w1_.x * lo_[j_ + 1] + w2_.x * lo_[j_ + 2] + w3_.x * lo_[j_ + 3]); \
            oh[j_] = fsilu(wb_.y + w0_.y * hi_[j_] + w1_.y * hi_[j_ + 1] + w2_.y * hi_[j_ + 2] + w3_.y * hi_[j_ + 3]); } } while (0)
typedef float f32x2 __attribute__((ext_vector_type(2)));
constexpr int IMG_BYTES = 98304;
__device__ __forceinline__ void ssd_prepass(Frame& F) {
    LAS unsigned char* L = F.lds; const int tid = F.tid;
    LAS float* cwt = (LAS float*)(L + TS_CW);
    for (int it = F.vcu; it < BATCH * 64 * 2; it += F.G) {
        const int g = it & 1, c = (it >> 1) & 63, b = it >> 7;
        for (int e = tid; e < 1280; e += NWAVES * 64) { const int k = e >> 8, ch = e & 255; const int cc = 1024 + (ch >> 7) * 256 + g * 128 + (ch & 127);
            cwt[320 + (ch >> 7) * 640 + k * 128 + (ch & 127)] = (k < 4) ? F_ssd_cw[k * XBC + cc] : F_ssd_cb[cc]; }
        const bf16* pj = F_PROJ + (size_t)(b * T) * NIN;
        const int co = tid & 15, q = tid >> 4, oB = PC_B + g * 128 + 8 * co, oC = oB + (PC_C - PC_B);
        v4u rb[7], rc[7];
        { const int tb = 128 * c + 4 * q - 3;
#pragma unroll
            for (int i = 0; i < 7; ++i) { const int t = tb + i < 0 ? 0 : tb + i; rb[i] = *(const GAS v4u*)(pj + (t * NIN + oB)); rc[i] = *(const GAS v4u*)(pj + (t * NIN + oC)); }
            if (c == 0 && q == 0) {
#pragma unroll
                for (int i = 0; i < 3; ++i) { rb[i] = (v4u){0u, 0u, 0u, 0u}; rc[i] = (v4u){0u, 0u, 0u, 0u}; } } }
        LDS_WAIT(); __syncthreads();
        {   v4u rowpk[4];
#pragma unroll
            for (int d = 0; d < 4; ++d) { float ol_[4], oh_[4]; SSD_CONV_PAIR(4, rb, cwt + 320 + 8 * co, 128, d, ol_, oh_);
#pragma unroll
                for (int j = 0; j < 4; ++j) rowpk[j][d] = pk2(ol_[j], oh_[j]);
                v2u t0; t0.x = pk2(ol_[0], ol_[1]); t0.y = pk2(ol_[2], ol_[3]); *(LAS v2u*)(L + TS_BCT + sswz(8 * co + 2 * d, 8 * q)) = t0;
                v2u t1; t1.x = pk2(oh_[0], oh_[1]); t1.y = pk2(oh_[2], oh_[3]); *(LAS v2u*)(L + TS_BCT + sswz(8 * co + 2 * d + 1, 8 * q)) = t1; }
#pragma unroll
            for (int j = 0; j < 4; ++j) *(LAS v4u*)(L + TS_BC + sswz(4 * q + j, 16 * co)) = rowpk[j];
#pragma unroll
            for (int d = 0; d < 4; ++d) { float ol_[4], oh_[4]; SSD_CONV_PAIR(4, rc, cwt + 960 + 8 * co, 128, d, ol_, oh_);
#pragma unroll
                for (int j = 0; j < 4; ++j) rowpk[j][d] = pk2(ol_[j], oh_[j]); }
#pragma unroll
            for (int j = 0; j < 4; ++j) *(LAS v4u*)(L + TS_CC + sswz(4 * q + j, 16 * co)) = rowpk[j];
        }
        LDS_WAIT(); __syncthreads();
        GAS v4u* img = (GAS v4u*)(F.ws + WS_IMG + (size_t)it * IMG_BYTES) + tid;
#pragma unroll
        for (int k = 0; k < 12; ++k) img[k * 512] = *(const LAS v4u*)(L + k * 8192 + tid * 16);
    }
}
__device__ __forceinline__ void ssd_unit(Frame& F, int unit) {
    const int b = unit >> 4, h = unit & 15, g = h >> 3, tid = F.tid, lane = F.lane, w = F.wave;
    LAS unsigned char* L = F.lds;
    LAS float* cwt = (LAS float*)(L + TS_CW);
    for (int e = tid; e < 320; e += NWAVES * 64) { const int k = e >> 6, c = h * 64 + (e & 63); cwt[e] = (k < 4) ? F_ssd_cw[k * XBC + c] : F_ssd_cb[c]; }
    for (int e = tid; e < 4096; e += NWAVES * 64) ((LAS unsigned*)(L + TS_S))[e] = 0u;
    const float A = -expf(F_ssd_alog[h]), Dh = F_ssd_d[h];
    const bf16* pj = F_PROJ + (size_t)(b * T) * NIN;
    const int oX = PC_X + h * 64 + 8 * (tid & 7), oZ = PC_Z + h * 64 + 16 * (tid & 3);
    const GAS v4u* imgp = (const GAS v4u*)(F.ws + WS_IMG + (size_t)((b * 64) * 2 + g) * IMG_BYTES) + tid;
    const float* pDT = F_DTV + (size_t)(b * T) * 16 + h;
    v4u ri[8], rt[4], rx[5], rz[2]; float dtp0 = 0.f, dtp1 = 0.f;
#define SSD_PREFETCH_BX(cc) do { const int tx_ = 128 * (cc) + 2 * (tid >> 3) - 3; const GAS v4u* ip_ = imgp + (size_t)(cc) * (2 * IMG_BYTES / 16); \
        _Pragma("unroll") for (int i_ = 0; i_ < 8; ++i_) ri[i_] = ip_[i_ * 512]; \
        _Pragma("unroll") for (int i_ = 0; i_ < 5; ++i_) { const int t_ = tx_ + i_ < 0 ? 0 : tx_ + i_; rx[i_] = *(const GAS v4u*)(pj + (t_ * NIN + oX)); } \
        if (w == 0) { dtp0 = pDT[(size_t)(128 * (cc) + 2 * lane) * 16]; dtp1 = pDT[(size_t)(128 * (cc) + 2 * lane + 1) * 16]; } } while (0)
#define SSD_PREFETCH_C(cc) do { const GAS v4u* ip_ = imgp + (size_t)(cc) * (2 * IMG_BYTES / 16); \
        _Pragma("unroll") for (int i_ = 0; i_ < 4; ++i_) rt[i_] = ip_[(8 + i_) * 512]; } while (0)
#define SSD_CUMSUM(par) do { LAS float* a_ = (LAS float*)(L + TS_ARR + (par) * 2048); const float a0_ = dtp0 * A, a1_ = dtp1 * A; float in_ = a0_ + a1_; \
        _Pragma("unroll") for (int d_ = 1; d_ < 64; d_ <<= 1) { const float t_ = __shfl_up(in_, d_); if (lane >= d_) in_ += t_; } \
        float ex_ = __shfl_up(in_, 1); if (lane == 0) ex_ = 0.f; const float cs0_ = ex_ + a0_, cs1_ = in_, ce_ = __shfl(in_, 63); \
        a_[2 * lane] = dtp0; a_[2 * lane + 1] = dtp1; a_[128 + 2 * lane] = cs0_; a_[129 + 2 * lane] = cs1_; a_[256 + 2 * lane] = __expf(cs0_); a_[257 + 2 * lane] = __expf(cs1_); \
        a_[384 + 2 * lane] = dtp0 * __expf(ce_ - cs0_); a_[385 + 2 * lane] = dtp1 * __expf(ce_ - cs1_); } while (0)
    SSD_PREFETCH_BX(0); SSD_PREFETCH_C(0);
    if (w == 0) SSD_CUMSUM(0);
    f32x16 Sacc;
#pragma unroll
    for (int i = 0; i < 16; ++i) Sacc[i] = 0.f;
    LDS_WAIT(); __syncthreads();
    const int s0 = 32 * (w >> 1), l0 = 64 * (w & 1), l0y = 32 * (w >> 1), p0 = 32 * (w & 1), n0 = l0y;
    for (int c = 0; c < 64; ++c) {
        const LAS float* dtl = (const LAS float*)(L + TS_ARR + (c & 1) * 2048); const LAS float* csl = dtl + 128; const LAS float* ecs = dtl + 256; const LAS float* wl = dtl + 384;
        int tq = tid; asm volatile("" : "+v"(tq));
        const int cx = tq & 7, qx = tq >> 3;
#pragma unroll
        for (int k = 0; k < 8; ++k) *(LAS v4u*)(L + k * 8192 + tq * 16) = ri[k];
#pragma unroll
        for (int k = 0; k < 4; ++k) *(LAS v4u*)(L + (8 + k) * 8192 + tq * 16) = rt[k];
        __builtin_amdgcn_sched_barrier(0);
        {   if (c == 0 && qx < 2) {
#pragma unroll
                for (int i = 0; i < 3; ++i) if (2 * qx - 3 + i < 0) rx[i] = (v4u){0u, 0u, 0u, 0u}; }
            const float w0 = wl[2 * qx], w1 = wl[2 * qx + 1];
#pragma unroll
            for (int d = 0; d < 4; ++d) { float ol_[2], oh_[2]; SSD_CONV_PAIR(2, rx, cwt + 8 * cx, 64, d, ol_, oh_);
                *(LAS unsigned*)(L + TS_SXT + sswz(8 * cx + 2 * d, 4 * qx)) = pk2(ol_[0], ol_[1]); *(LAS unsigned*)(L + TS_XSDT + sswz(8 * cx + 2 * d, 4 * qx)) = pk2(ol_[0] * w0, ol_[1] * w1);
                *(LAS unsigned*)(L + TS_SXT + sswz(8 * cx + 2 * d + 1, 4 * qx)) = pk2(oh_[0], oh_[1]); *(LAS unsigned*)(L + TS_XSDT + sswz(8 * cx + 2 * d + 1, 4 * qx)) = pk2(oh_[0] * w0, oh_[1] * w1); }
        }
        __builtin_amdgcn_sched_barrier(0);
        __builtin_amdgcn_sched_barrier(0);
        const int cn = c < 63 ? c + 1 : 63; SSD_PREFETCH_BX(cn);
        rz[0] = *(const GAS v4u*)(pj + ((128 * c + (tid >> 2)) * NIN + oZ)); rz[1] = *(const GAS v4u*)(pj + ((128 * c + (tid >> 2)) * NIN + oZ + 8));
        LDS_WAIT(); __syncthreads();
        int tm = tid; asm volatile("" : "+v"(tm)); const int r = tm & 31, hh = (tm >> 5) & 1;
        f32x16 sc0, sc1, yacc;
#pragma unroll
        for (int i = 0; i < 16; ++i) { sc0[i] = 0.f; sc1[i] = 0.f; yacc[i] = 0.f; }
        {   const int ra = s0 + r, rb0 = l0 + r, rb1 = l0 + 32 + r;
            const int ba = TS_BC + ra * 256, ka = skey(ra) ^ hh, bb0 = TS_CC + rb0 * 256, kb0 = skey(rb0) ^ hh, bb1 = TS_CC + rb1 * 256, kb1 = skey(rb1) ^ hh;
#pragma unroll
            for (int ks = 0; ks < 8; ++ks) { const bf16x8 a = *(const LAS bf16x8*)(L + ba + (((2 * ks) ^ ka) << 4));
                const bf16x8 f0 = *(const LAS bf16x8*)(L + bb0 + (((2 * ks) ^ kb0) << 4)), f1 = *(const LAS bf16x8*)(L + bb1 + (((2 * ks) ^ kb1) << 4));
                sc0 = MFMA32(a, f0, sc0); sc1 = MFMA32(a, f1, sc1); if (ks & 1) __builtin_amdgcn_sched_barrier(0); }
        }
        const int ry = l0y + r, byA = ry * 256, kyA = skey(ry) ^ hh;
        const int rp = p0 + r, bpB = rp * 256, kpB = skey(rp) ^ hh;
#pragma unroll
        for (int ks = 0; ks < 8; ++ks) { const bf16x8 a = *(const LAS bf16x8*)(L + TS_CC + byA + (((2 * ks) ^ kyA) << 4)), f = *(const LAS bf16x8*)(L + TS_S + bpB + (((2 * ks) ^ kpB) << 4));
            yacc = MFMA32(a, f, yacc); if ((ks & 3) == 3) __builtin_amdgcn_sched_barrier(0); }
#pragma unroll
        for (int q4 = 0; q4 < 4; ++q4) { const f32x4 e4 = *(const LAS f32x4*)(ecs + l0y + 8 * q4 + 4 * hh);
            yacc[4 * q4 + 0] *= e4.x; yacc[4 * q4 + 1] *= e4.y; yacc[4 * q4 + 2] *= e4.z; yacc[4 * q4 + 3] *= e4.w; }
        LDS_WAIT(); __syncthreads();
#pragma unroll
        for (int j = 0; j < 2; ++j) { const int l = l0 + 32 * j + r; const float cl = csl[l];
#pragma unroll
            for (int q4 = 0; q4 < 4; ++q4) { const int sb = s0 + 8 * q4 + 4 * hh; const f32x4 cs4 = *(const LAS f32x4*)(csl + sb), dt4 = *(const LAS f32x4*)(dtl + sb); float m[4];
#pragma unroll
                for (int i = 0; i < 4; ++i) { const float sv = j ? sc1[4 * q4 + i] : sc0[4 * q4 + i]; const float v = sv * __expf(cl - cs4[i]) * dt4[i]; m[i] = (l >= sb + i) ? v : 0.f; }
                v2u pk; pk.x = pk2(m[0], m[1]); pk.y = pk2(m[2], m[3]); *(LAS v2u*)(L + TS_CC + sswz(l, 2 * sb)) = pk; } }
        SSD_PREFETCH_C(cn);
        LDS_WAIT(); __syncthreads();
#pragma unroll
        for (int ks = 0; ks < 8; ++ks) { const bf16x8 a = *(const LAS bf16x8*)(L + TS_CC + byA + (((2 * ks) ^ kyA) << 4)), f = *(const LAS bf16x8*)(L + TS_SXT + bpB + (((2 * ks) ^ kpB) << 4));
            yacc = MFMA32(a, f, yacc); if ((ks & 3) == 3) __builtin_amdgcn_sched_barrier(0); }
        { const float dec = ecs[127];
#pragma unroll
            for (int i = 0; i < 16; ++i) Sacc[i] *= dec; }
#pragma unroll
        for (int ks = 0; ks < 8; ++ks) { const bf16x8 a = *(const LAS bf16x8*)(L + TS_BCT + byA + (((2 * ks) ^ kyA) << 4)), f = *(const LAS bf16x8*)(L + TS_XSDT + bpB + (((2 * ks) ^ kpB) << 4));
            Sacc = MFMA32(a, f, Sacc); if ((ks & 3) == 3) __builtin_amdgcn_sched_barrier(0); }
#pragma unroll
        for (int q4 = 0; q4 < 4; ++q4) { const int lb = l0y + 8 * q4 + 4 * hh; const v2u sw = *(const LAS v2u*)(L + TS_SXT + sswz(rp, 2 * lb));
            yacc[4 * q4 + 0] += Dh * bflo(sw.x); yacc[4 * q4 + 1] += Dh * bfhi(sw.x); yacc[4 * q4 + 2] += Dh * bflo(sw.y); yacc[4 * q4 + 3] += Dh * bfhi(sw.y); }
        int t5 = tid; asm volatile("" : "+v"(t5)); const int r5 = t5 & 31, h5 = (t5 >> 5) & 1, rp5 = p0 + r5;
#pragma unroll
        for (int i = 0; i < 16; ++i) { const int l = l0y + (i & 3) + 8 * (i >> 2) + 4 * h5; *(LAS float*)(L + TS_BC + l * 256 + ((((rp5 >> 2) ^ skey(l)) & 15) << 4) + (rp5 & 3) * 4) = yacc[i]; }
#pragma unroll
        for (int q4 = 0; q4 < 4; ++q4) { const int nb = n0 + 8 * q4 + 4 * h5; v2u pk; pk.x = pk2(Sacc[4 * q4], Sacc[4 * q4 + 1]); pk.y = pk2(Sacc[4 * q4 + 2], Sacc[4 * q4 + 3]); *(LAS v2u*)(L + TS_S + sswz(rp5, 2 * nb)) = pk; }
        LDS_WAIT(); __syncthreads();
        {   int to = tid; asm volatile("" : "+v"(to)); const int ol = to >> 2, opq = to & 3;
            float yv[16], zf[16];
#pragma unroll
            for (int i = 0; i < 4; ++i) { const f32x4 t4 = *(const LAS f32x4*)(L + TS_BC + ol * 256 + ((((4 * opq + i) ^ skey(ol)) & 15) << 4)); yv[4 * i] = t4.x; yv[4 * i + 1] = t4.y; yv[4 * i + 2] = t4.z; yv[4 * i + 3] = t4.w; }
#pragma unroll
            for (int e = 0; e < 8; ++e) { zf[e] = bfsel(rz[0], e); zf[8 + e] = bfsel(rz[1], e); }
            float ss = 0.f;
#pragma unroll
            for (int k = 0; k < 16; ++k) { yv[k] = yv[k] * fsilu(zf[k]); ss += yv[k] * yv[k]; }
            ss += __shfl_xor(ss, 1); ss += __shfl_xor(ss, 2);
            const size_t row = (size_t)(b * T + 128 * c + ol);
            v4u o0, o1; o0.x = pk2(yv[0], yv[1]); o0.y = pk2(yv[2], yv[3]); o0.z = pk2(yv[4], yv[5]); o0.w = pk2(yv[6], yv[7]); o1.x = pk2(yv[8], yv[9]); o1.y = pk2(yv[10], yv[11]); o1.z = pk2(yv[12], yv[13]); o1.w = pk2(yv[14], yv[15]);
            GAS v4u* op = (GAS v4u*)(F_YMIX + row * MIXW + 1024 + h * 64 + 16 * opq); op[0] = o0; op[1] = o1;
            if (opq == 0) F_PART[row * 32 + 16 + h] = ss;
        }
        if (w == 0) SSD_CUMSUM((c + 1) & 1);
        LDS_WAIT(); __syncthreads();
    }
#undef SSD_PREFETCH_BX
#undef SSD_PREFETCH_C
#undef SSD_CUMSUM
}

constexpr int TL_LXA = 0, TL_G = 32768, TL_Y = 65536, TL_COMP = 98304, TL_CW = 102400, TL_WF = 106496;
#define LRU_CONV_PAIR(raw, cw, d, ol, oh) do { \
        const f32x2 w0_ = *(const LAS f32x2*)((cw) + 2 * (d)), w1_ = *(const LAS f32x2*)((cw) + 64 + 2 * (d)), w2_ = *(const LAS f32x2*)((cw) + 128 + 2 * (d)), w3_ = *(const LAS f32x2*)((cw) + 192 + 2 * (d)), wb_ = *(const LAS f32x2*)((cw) + 256 + 2 * (d)); \
        float lo_[7], hi_[7]; \
        _Pragma("unroll") for (int i_ = 0; i_ < 7; ++i_) { lo_[i_] = bflo((raw)[i_][d]); hi_[i_] = bfhi((raw)[i_][d]); } \
        _Pragma("unroll") for (int j_ = 0; j_ < 4; ++j_) { \
            ol[j_] = wb_.x + w0_.x * lo_[j_] + w1_.x * lo_[j_ + 1] + w2_.x * lo_[j_ + 2] + w3_.x * lo_[j_ + 3]; \
            oh[j_] = wb_.y + w0_.y * hi_[j_] + w1_.y * hi_[j_ + 1] + w2_.y * hi_[j_ + 2] + w3_.y * hi_[j_ + 3]; } } while (0)
__device__ __forceinline__ float fsigmoid(float v) { return __builtin_amdgcn_rcpf(1.0f + __expf(-v)); }
__device__ __forceinline__ void lru_unit(Frame& F, int unit) {
    const int b = unit >> 4, blk = unit & 15, tid = F.tid, lane = F.lane, w = F.wave;
    LAS unsigned char* L = F.lds;
    LAS float* cwt = (LAS float*)(L + TL_CW);
    for (int e = tid; e < 320; e += NWAVES * 64) { const int k = e >> 6, ch = blk * 64 + (e & 63); cwt[e] = (k < 4) ? F_lru_cw[k * 1024 + ch] : F_lru_cb[ch]; }
    {   const int r = lane & 31, hh = lane >> 5;
        for (int f = w; f < 16; f += NWAVES) { const int m = f >> 3, jb = (f >> 2) & 1, ks = f & 3; const float* s = (m ? F_lru_wx : F_lru_wa) + blk * 4096 + (16 * ks + 8 * hh) * 64 + 32 * jb + r;
            v4u pk; pk.x = pk2(s[0], s[64]); pk.y = pk2(s[128], s[192]); pk.z = pk2(s[256], s[320]); pk.w = pk2(s[384], s[448]);
            *(LAS v4u*)(L + TL_WF + f * 1024 + lane * 16) = pk; }
    }
    float ba[2], bx[2], sp8[2], hcar[2];
#pragma unroll
    for (int jb = 0; jb < 2; ++jb) { const int ch = blk * 64 + 32 * jb + (lane & 31); ba[jb] = F_lru_ba[ch]; bx[jb] = F_lru_bx[ch]; sp8[jb] = -8.0f * softplusf_(-F_lru_lam[ch]); hcar[jb] = 0.f; }
    const bf16* pj = F_PROJ + (size_t)(b * T) * NIN;
    const int oX = PC_LX + blk * 64 + 8 * (tid & 7), oG = PC_LG + blk * 64 + 8 * (tid & 7);
    v4u rxl[7], rg[4];
#define LRU_PREFETCH(cc) do { const int tb_ = 256 * (cc) + 4 * (tid >> 3) - 3; \
        _Pragma("unroll") for (int i_ = 0; i_ < 7; ++i_) { const int t_ = tb_ + i_ < 0 ? 0 : tb_ + i_; rxl[i_] = *(const GAS v4u*)(pj + (t_ * NIN + oX)); } \
        _Pragma("unroll") for (int i_ = 0; i_ < 4; ++i_) rg[i_] = *(const GAS v4u*)(pj + ((tb_ + 3 + i_) * NIN + oG)); } while (0)
    LRU_PREFETCH(0);
    LDS_WAIT(); __syncthreads();
    for (int c = 0; c < 32; ++c) {
        {   int tq = tid; asm volatile("" : "+v"(tq)); const int co = tq & 7, q = tq >> 3;
            if (c == 0 && q == 0) {
#pragma unroll
                for (int i = 0; i < 3; ++i) rxl[i] = (v4u){0u, 0u, 0u, 0u}; }
            v4u rowpk[4];
#pragma unroll
            for (int d = 0; d < 4; ++d) { float ol_[4], oh_[4]; LRU_CONV_PAIR(rxl, cwt + 8 * co, d, ol_, oh_);
#pragma unroll
                for (int j = 0; j < 4; ++j) rowpk[j][d] = pk2(ol_[j], oh_[j]); }
#pragma unroll
            for (int j = 0; j < 4; ++j) { const int row = 4 * q + j; *(LAS v4u*)(L + TL_LXA + row * 128 + ((co ^ ((row >> 1) & 7)) << 4)) = rowpk[j]; *(LAS v4u*)(L + TL_G + row * 128 + co * 16) = rg[j]; }
        }
        __builtin_amdgcn_sched_barrier(0);
        { const int cn = c < 31 ? c + 1 : 31; LRU_PREFETCH(cn); }
        LDS_WAIT(); __syncthreads();
        int tm = tid; asm volatile("" : "+v"(tm)); const int r = tm & 31, hh = (tm >> 5) & 1;
        f32x16 accR[2], accI[2];
#pragma unroll
        for (int jb = 0; jb < 2; ++jb)
#pragma unroll
            for (int i = 0; i < 16; ++i) { accR[jb][i] = 0.f; accI[jb][i] = 0.f; }
        {   const int row = 32 * w + r, base = TL_LXA + row * 128, ka = ((row >> 1) & 7) ^ hh;
#pragma unroll
            for (int ks = 0; ks < 4; ++ks) { const bf16x8 a = *(const LAS bf16x8*)(L + base + (((2 * ks) ^ ka) << 4));
                const LAS unsigned char* wb = L + TL_WF + ks * 1024 + (tm & 63) * 16;
                accR[0] = MFMA32(a, *(const LAS bf16x8*)(wb), accR[0]); accR[1] = MFMA32(a, *(const LAS bf16x8*)(wb + 4096), accR[1]);
                accI[0] = MFMA32(a, *(const LAS bf16x8*)(wb + 8192), accI[0]); accI[1] = MFMA32(a, *(const LAS bf16x8*)(wb + 12288), accI[1]); }
        }
        float eA[2][4], eH[2][4];
#pragma unroll
        for (int jb = 0; jb < 2; ++jb) { const int ch = 32 * jb + r; float gA[4], gH[4];
#pragma unroll
            for (int qg = 0; qg < 4; ++qg) { float hp = 0.f, pp = 1.f;
#pragma unroll
                for (int i = 0; i < 4; ++i) { const int reg = 4 * qg + i, t = 32 * w + 8 * qg + 4 * hh + i;
                    const float rr = fsigmoid(accR[jb][reg] + ba[jb]), ii = fsigmoid(accI[jb][reg] + bx[jb]);
                    const float a = __expf(sp8[jb] * rr), mult = __builtin_amdgcn_sqrtf(fmaxf(1.0f - a * a, 0.f));
                    const float lx = bf2f(*(const LAS bf16*)(L + TL_LXA + t * 128 + ((((ch >> 3) ^ ((t >> 1) & 7))) << 4) + (ch & 7) * 2));
                    hp = a * hp + mult * (ii * lx); pp = a * pp; accR[jb][reg] = hp; accI[jb][reg] = pp; }
                gA[qg] = pp; gH[qg] = hp; }
            float cA = 1.f, cH = 0.f;
#pragma unroll
            for (int qg = 0; qg < 4; ++qg) { const float pA = __shfl_xor(gA[qg], 32), pH = __shfl_xor(gH[qg], 32);
                const float A1 = hh ? pA : gA[qg], H1 = hh ? pH : gH[qg], A2 = hh ? gA[qg] : pA, H2 = hh ? gH[qg] : pH;
                const float bA = cA, bH = cH; cH = A1 * cH + H1; cA = A1 * cA; const float mA = cA, mH = cH; cH = A2 * cH + H2; cA = A2 * cA;
                eA[jb][qg] = hh ? mA : bA; eH[jb][qg] = hh ? mH : bH; }
            if (hh == 0) { LAS float* cp = (LAS float*)(L + TL_COMP) + (w * 64 + ch) * 2; cp[0] = cA; cp[1] = cH; }
        }
        LDS_WAIT(); __syncthreads();
#pragma unroll
        for (int jb = 0; jb < 2; ++jb) { const int ch = 32 * jb + r; float run = hcar[jb], cin = 0.f;
#pragma unroll
            for (int wp = 0; wp < 8; ++wp) { const f32x2 cm = *(const LAS f32x2*)((const LAS float*)(L + TL_COMP) + (wp * 64 + ch) * 2); if (wp == w) cin = run; run = cm.x * run + cm.y; }
            hcar[jb] = run;
#pragma unroll
            for (int qg = 0; qg < 4; ++qg) { const float cg = eA[jb][qg] * cin + eH[jb][qg];
#pragma unroll
                for (int i = 0; i < 4; ++i) { const int reg = 4 * qg + i, t = 32 * w + 8 * qg + 4 * hh + i;
                    const float hv = accR[jb][reg] + accI[jb][reg] * cg;
                    const float gt = bf2f(*(const LAS bf16*)(L + TL_G + t * 128 + ch * 2));
                    const float z2 = 1.5957691216057308f * (gt + 0.044715f * gt * gt * gt);
                    const float y = hv * gt * fsigmoid(z2);
                    *(LAS bf16*)(L + TL_Y + t * 128 + ch * 2) = (bf16)f2bf(y); } }
        }
        LDS_WAIT(); __syncthreads();
        {   int to = tid; asm volatile("" : "+v"(to)); const int t = to >> 1, hf = to & 1;
            const LAS v4u* yp = (const LAS v4u*)(L + TL_Y + t * 128 + hf * 64); v4u yv[4]; float ss = 0.f;
#pragma unroll
            for (int i = 0; i < 4; ++i) { yv[i] = yp[i];
#pragma unroll
                for (int d = 0; d < 4; ++d) { const float lo = bflo(yv[i][d]), hi = bfhi(yv[i][d]); ss += lo * lo + hi * hi; } }
            ss += __shfl_xor(ss, 1);
            const size_t row = (size_t)(b * T + 256 * c + t);
            GAS v4u* op = (GAS v4u*)(F_YMIX + row * MIXW + blk * 64 + 32 * hf);
#pragma unroll
            for (int i = 0; i < 4; ++i) op[i] = yv[i];
            if (hf == 0) F_PART[row * 32 + blk] = ss;
        }
    }
    __syncthreads();
#undef LRU_PREFETCH
}

template <bool DO_SSD, bool DO_LRU> __device__ __forceinline__ void p2_mixer(Frame& F) {
    const int i = F.vcu;
    if (i < 256) { const int unit = (i >> 5) * 16 + (i & 15);
        if ((i & 31) < 16) { if (DO_SSD) {
#if USE_SSD_OPT
            ssd_unit(F, unit);
#else
            ssd_baseline_unit(F, unit);
#endif
        } } else if (DO_LRU) {
#if USE_LRU_OPT == 1
            lru_unit(F, unit);
#elif USE_LRU_OPT == 2
            (void)unit;
#else
            if (F.wave == 0) lru_baseline_unit(F, unit);
#endif
        }
    }
}
__device__ __forceinline__ void p3_ymix_norm(Frame& F) {
    const int gw = F.vcu * NWAVES + F.wave, NGW = F.G * NWAVES, lane = F.lane;
    float gn[4][8];
#pragma unroll
    for (int j = 0; j < 4; ++j)
#pragma unroll
        for (int e = 0; e < 8; ++e) { const int c = 8 * lane + 512 * j + e; gn[j][e] = (j < 2) ? F_g_lru[c] : F_g_ssd[c - 1024]; }
    for (int row = gw; row < M; row += NGW) {
        float s = F_PART[(size_t)row * 32 + (lane & 31)];
        s += __shfl_xor(s, 1); s += __shfl_xor(s, 2); s += __shfl_xor(s, 4); s += __shfl_xor(s, 8);
        const float sl = __shfl(s, 0), ssd = __shfl(s, 16);
        const float rl = 1.0f / sqrtf(sl * (1.0f / 1024.0f) + EPS), rs = 1.0f / sqrtf(ssd * (1.0f / 1024.0f) + EPS);
        GAS v4u* yp = (GAS v4u*)(F_YMIX + (size_t)row * MIXW) + lane;
#pragma unroll
        for (int j = 0; j < 4; ++j) { const v4u w = yp[64 * j]; const float sc = (j < 2) ? rl : rs; v4u o;
            o.x = pk2(bflo(w.x) * sc * gn[j][0], bfhi(w.x) * sc * gn[j][1]); o.y = pk2(bflo(w.y) * sc * gn[j][2], bfhi(w.y) * sc * gn[j][3]);
            o.z = pk2(bflo(w.z) * sc * gn[j][4], bfhi(w.z) * sc * gn[j][5]); o.w = pk2(bflo(w.w) * sc * gn[j][6], bfhi(w.w) * sc * gn[j][7]);
            yp[64 * j] = o; }
    }
}
__device__ __forceinline__ void p5_post_mix(Frame& F) {
    const int gw = F.vcu * NWAVES + F.wave, NGW = F.G * NWAVES, lane = F.lane;
    f32x4 gm[4], gf[4];
#pragma unroll
    for (int j = 0; j < 4; ++j) { gm[j] = *(const f32x4*)(F_g_pm + 4 * lane + 256 * j); gf[j] = *(const f32x4*)(F_g_pf + 4 * lane + 256 * j); }
    for (int row = gw; row < M; row += NGW) {
        const GAS unsigned long long* mp = (const GAS unsigned long long*)(F_MIXF + (size_t)row * D) + lane;
        const GAS f32x4* xp = (const GAS f32x4*)(F_x + (size_t)row * D) + lane;
        f32x4 mv[4], xv[4]; float ss = 0.f;
#pragma unroll
        for (int j = 0; j < 4; ++j) { const unsigned long long w = mp[64 * j]; const unsigned lo = (unsigned)w, hi = (unsigned)(w >> 32);
            mv[j] = (f32x4){bflo(lo), bfhi(lo), bflo(hi), bfhi(hi)}; xv[j] = xp[64 * j];
            ss += (mv[j].x * mv[j].x + mv[j].y * mv[j].y) + (mv[j].z * mv[j].z + mv[j].w * mv[j].w); }
        const float rm = 1.0f / sqrtf(wave_sum(ss) * (1.0f / D) + EPS);
        float s1 = 0.f;
        GAS f32x4* op = (GAS f32x4*)(F.out + (size_t)row * D) + lane;
#pragma unroll
        for (int j = 0; j < 4; ++j) { xv[j] = xv[j] + mv[j] * rm * gm[j]; op[64 * j] = xv[j];
            s1 += (xv[j].x * xv[j].x + xv[j].y * xv[j].y) + (xv[j].z * xv[j].z + xv[j].w * xv[j].w); }
        const float r1 = 1.0f / sqrtf(wave_sum(s1) * (1.0f / D) + EPS);
        GAS unsigned long long* hp = (GAS unsigned long long*)(F_XN + (size_t)row * D) + lane;
#pragma unroll
        for (int j = 0; j < 4; ++j) { const f32x4 hv = xv[j] * r1 * gf[j]; hp[64 * j] = (unsigned long long)pk2(hv.x, hv.y) | ((unsigned long long)pk2(hv.z, hv.w) << 32); }
    }
}
__device__ __forceinline__ void p8_post_ffn(Frame& F) {
    const int gw = F.vcu * NWAVES + F.wave, NGW = F.G * NWAVES, lane = F.lane;
    f32x4 gp[4];
#pragma unroll
    for (int j = 0; j < 4; ++j) gp[j] = *(const f32x4*)(F_g_post + 4 * lane + 256 * j);
    for (int row = gw; row < M; row += NGW) {
        const GAS unsigned long long* mp = (const GAS unsigned long long*)(F_MIXF + (size_t)row * D) + lane;
        GAS f32x4* op = (GAS f32x4*)(F.out + (size_t)row * D) + lane;
        f32x4 mv[4], xv[4]; float ss = 0.f;
#pragma unroll
        for (int j = 0; j < 4; ++j) { const unsigned long long w = mp[64 * j]; const unsigned lo = (unsigned)w, hi = (unsigned)(w >> 32);
            mv[j] = (f32x4){bflo(lo), bfhi(lo), bflo(hi), bfhi(hi)}; xv[j] = op[64 * j];
            ss += (mv[j].x * mv[j].x + mv[j].y * mv[j].y) + (mv[j].z * mv[j].z + mv[j].w * mv[j].w); }
        const float rm = 1.0f / sqrtf(wave_sum(ss) * (1.0f / D) + EPS);
#pragma unroll
        for (int j = 0; j < 4; ++j) op[64 * j] = xv[j] + mv[j] * rm * gp[j];
    }
}

struct Args { const float* in[24]; float* out; unsigned char* ws; int ph_lo, ph_hi, li, pad; };
template <unsigned MASK> __global__ void __launch_bounds__(NWAVES * 64, 2) hyb_fwd(Args args) {
    extern __shared__ __attribute__((aligned(16))) unsigned char lds[];
    Frame F;
    F.lds = (LAS unsigned char*)lds;
    F.MISC = (volatile LAS unsigned*)(F.lds + MISC_OFF);
    F.tid = threadIdx.x; F.lane = F.tid & 63; F.wave = __builtin_amdgcn_readfirstlane(F.tid >> 6);
    F.G = gridDim.x; { const int bx = blockIdx.x; F.vcu = (F.G % 8 == 0) ? (bx % 8) * (F.G / 8) + bx / 8 : bx; }
    unsigned char* ws = args.ws;
    F.ctl = (gu32*)(ws + WS_CTL);
    F.in = args.in; F.out = args.out; F.ws = ws;
    for (int u = F.tid; u < (LDS_BYTES - LDSCTL_OFF) / 4; u += NWAVES * 64) ((LAS unsigned*)(F.lds + LDSCTL_OFF))[u] = 0u;
    __syncthreads();
    XcdBarrier bar; bar.bar = (unsigned*)(F.ctl + CW_BAR); bar.x = 0; bar.st = nullptr;
    if (N_LAUNCHES == 1) bar = xcd_barrier_post((unsigned*)(F.ctl + CW_BAR), F.MISC + 8);
#define GRID_BAR() do { if (N_LAUNCHES == 1) xcd_barrier(bar); } while (0)
    const int lo = args.ph_lo, hi = args.ph_hi;
#define IN(k) (((MASK >> (k)) & 1u) && lo <= (k) && (k) < hi)
#define BOTH(k) (IN(k) && IN((k) + 1))
#ifndef REPMASK
#define REPMASK 0u
#endif
#define REPS(k) for (int rep_ = 0; rep_ < (((REPMASK >> (k)) & 1u) ? 2 : 1); ++rep_)

    if (IN(0)) REPS(0) { p0_prologue(F); if (BOTH(0)) GRID_BAR(); }
    if (IN(1)) REPS(1) {
        pg8::Gemm g{F_XN, F_Win_t, M, NIN, D}; pg8::StaticOrder S; S.init(M, NIN, F.G, (int)blockIdx.x);
        pg8::EpiBf16<0> E{F_PROJ, NIN, nullptr, 0, 0, 1.f};
        pg8::gemm_phase<pg8::EpiBf16<0>, pg8::StaticOrder, PG8_ALIGN, PG8_SP2>(F.lds + RING_OFF, g, S, E);
        if (BOTH(1)) GRID_BAR();
    }
    if (((MASK >> 9) & 1u) && lo <= 2 && 2 < hi) { ssd_prepass(F); if (IN(2)) GRID_BAR(); }
    if (IN(2)) REPS(2) { p2_mixer<!((MASK >> 16) & 1u), !((MASK >> 17) & 1u)>(F); if (BOTH(2)) GRID_BAR(); }
    if (IN(3)) REPS(3) { p3_ymix_norm(F); if (BOTH(3)) GRID_BAR(); }
    if (IN(4)) REPS(4) {
        pg8::Gemm g{F_YMIX, F_Wout_t, M, D, MIXW}; pg8::StaticOrder S; S.init(M, D, F.G, (int)blockIdx.x);
        pg8::EpiBf16<0> E{F_MIXF, D, nullptr, 0, 0, 1.f};
        pg8::gemm_phase<pg8::EpiBf16<0>, pg8::StaticOrder, PG8_ALIGN, PG8_SP2>(F.lds + RING_OFF, g, S, E);
        if (BOTH(4)) GRID_BAR();
    }
    if (IN(5)) REPS(5) { p5_post_mix(F); if (BOTH(5)) GRID_BAR(); }
    if (IN(6)) REPS(6) {
        pg8::Gemm g{F_XN, F_Wgu_t, M, NGU, D}; pg8::StaticOrder S; S.init(M, NGU, F.G, (int)blockIdx.x);
        pg8::EpiSwiGLU E{F_HID, FF};
        pg8::gemm_phase<pg8::EpiSwiGLU, pg8::StaticOrder, PG8_ALIGN, PG8_SP2>(F.lds + RING_OFF, g, S, E);
        if (BOTH(6)) GRID_BAR();
    }
    if (IN(7)) REPS(7) {
        pg8::Gemm g{F_HID, F_Wd_t, M, D, FF}; pg8::StaticOrder S; S.init(M, D, F.G, (int)blockIdx.x);
        pg8::EpiBf16<0> E{F_MIXF, D, nullptr, 0, 0, 1.f};
        pg8::gemm_phase<pg8::EpiBf16<0>, pg8::StaticOrder, PG8_ALIGN, PG8_SP2>(F.lds + RING_OFF, g, S, E);
        if (BOTH(7)) GRID_BAR();
    }
    if (IN(8)) { p8_post_ffn(F); }
#undef IN
#undef BOTH
}

#ifndef PHMASK
#define PHMASK 0x3ffu
#endif
template <unsigned MASK> static void launch_one(int grid, hipStream_t stream, Args a) { hipLaunchKernelGGL(hyb_fwd<MASK>, dim3(grid), dim3(NWAVES * 64), LDS_BYTES, stream, a); }
template <unsigned MASK> static bool prep_one(int* per_cu) {
    if (hipFuncSetAttribute((const void*)hyb_fwd<MASK>, hipFuncAttributeMaxDynamicSharedMemorySize, LDS_BYTES) != hipSuccess) return false;
    return hipOccupancyMaxActiveBlocksPerMultiprocessor(per_cu, (const void*)hyb_fwd<MASK>, NWAVES * 64, LDS_BYTES) == hipSuccess && *per_cu >= 1;
}
extern "C" void kernel_launch(void* const* d_in, const int* in_sizes, int n_in, void* d_out, int out_size, void* d_ws, size_t ws_size, hipStream_t stream) {
    static int grid = 0;
    if (grid == 0) {
        if (n_in != 24 || in_sizes[0] != M * D || out_size != M * D || ws_size < WS_END) { fprintf(stderr, "kernel_launch: unexpected shapes: n_in %d in0 %d out %d ws %zu\n", n_in, n_in > 0 ? in_sizes[0] : -1, out_size, ws_size); grid = -1; return; }
        int dev = 0, cus = 0, per_cu = 0; bool ok = true;
        if (hipGetDevice(&dev) != hipSuccess || hipDeviceGetAttribute(&cus, hipDeviceAttributeMultiprocessorCount, dev) != hipSuccess) { grid = -1; return; }
#if MK_N_LAUNCHES == 1
        ok = prep_one<PHMASK>(&per_cu);
#else
        ok = prep_one<0x001u>(&per_cu) && prep_one<0x002u>(&per_cu) && prep_one<0x200u>(&per_cu) && prep_one<0x20004u>(&per_cu) && prep_one<0x10004u>(&per_cu) && prep_one<0x008u>(&per_cu) && prep_one<0x010u>(&per_cu) && prep_one<0x020u>(&per_cu) && prep_one<0x040u>(&per_cu) && prep_one<0x080u>(&per_cu) && prep_one<0x100u>(&per_cu);
#endif
        if (!ok) { fprintf(stderr, "kernel_launch: LDS attribute / occupancy query failed (%d blocks per CU)\n", per_cu); (void)hipGetLastError(); grid = -1; return; }
        if (cus < 256) { fprintf(stderr, "kernel_launch: built for a 256-CU device, found %d CUs\n", cus); grid = -1; return; }
        grid = 256;
    }
    if (grid < 0) return;
    (void)hipMemsetAsync((char*)d_ws + WS_CTL, 0, CTL_ZERO_BYTES, stream);
    Args a{};
    for (int i = 0; i < 24; ++i) a.in[i] = (const float*)d_in[i];
    a.out = (float*)d_out; a.ws = (unsigned char*)d_ws;
#if MK_N_LAUNCHES == 1
    a.ph_lo = 0; a.ph_hi = NPH; a.li = 0; launch_one<PHMASK>(grid, stream, a);
#else
    a.ph_lo = 0; a.ph_hi = NPH;
    launch_one<0x001u>(grid, stream, a); launch_one<0x002u>(grid, stream, a); launch_one<0x200u>(grid, stream, a); launch_one<0x20004u>(grid, stream, a); launch_one<0x10004u>(grid, stream, a); launch_one<0x008u>(grid, stream, a);
    launch_one<0x010u>(grid, stream, a); launch_one<0x020u>(grid, stream, a); launch_one<0x040u>(grid, stream, a); launch_one<0x080u>(grid, stream, a); launch_one<0x100u>(grid, stream, a);
#endif
}
```
